# Optimizing an MI355X kernel written in HIP

```python
import math
import jax, jax.numpy as jnp
from jax import lax
import numpy as np

D_MODEL = 1024
BATCH = 8
SEQ = 4096
DEPTH = 1

GRID_W = 64
CTX_LEN = 256
N_MLA_HEADS = 8
QK_NOPE_DIM = 64
QK_ROPE_DIM = 32
V_HEAD_DIM = 64
Q_LORA_RANK = 384
KV_LORA_RANK = 256
MLA_WIDTH = N_MLA_HEADS * V_HEAD_DIM
S5_WIDTH = D_MODEL - MLA_WIDTH
S5_GROUP = 16
S5_GROUPS = S5_WIDTH // S5_GROUP
S5_STATE = 64
DT_MIN = 1e-3
DT_MAX = 1e-1
KV_END = Q_LORA_RANK + KV_LORA_RANK
ROPE_END = KV_END + QK_ROPE_DIM
D_IN = ROPE_END + S5_WIDTH
D_FF = ((8 * D_MODEL + 3 * 256 - 1) // (3 * 256)) * 256
ROPE_THETA = 10000.0
Q_BLOCK = 128
NORM_EPS = 1e-6
DN_ALPHA = (2.0 * DEPTH) ** 0.25
DN_BETA = (8.0 * DEPTH) ** -0.25

kernel_name = 'hymba_mla_s5_deepnorm_adaln_prefix_ctx'


def layer_norm(x, g=None, b=None):
    xf = x.astype(jnp.float32)
    mu = xf.mean(-1, keepdims=True)
    var = jnp.square(xf - mu).mean(-1, keepdims=True)
    y = (xf - mu) * lax.rsqrt(var + NORM_EPS)
    if g is not None:
        y = y * g.astype(jnp.float32) + b.astype(jnp.float32)
    return y.astype(x.dtype)


def rms_norm(x, g):
    xf = x.astype(jnp.float32)
    y = xf * lax.rsqrt(jnp.mean(xf * xf, -1, keepdims=True) + NORM_EPS)
    return (y * g.astype(jnp.float32)).astype(x.dtype)


def adaln(cond, w_ada, b_ada):
    return jnp.split(jax.nn.silu(cond) @ w_ada + b_ada, 6, axis=-1)


def modulate(x, shift, scale):
    return layer_norm(x) * (1 + scale) + shift


def axial_rope(rows):
    row = jnp.repeat(jnp.arange(rows), GRID_W).astype(jnp.float32)
    col = jnp.tile(jnp.arange(GRID_W), rows).astype(jnp.float32)
    n_freq = QK_ROPE_DIM // 4
    freqs = ROPE_THETA ** (-jnp.arange(n_freq, dtype=jnp.float32) / n_freq)
    ang = jnp.concatenate([row[:, None] * freqs, col[:, None] * freqs], axis=-1)
    return jnp.cos(ang), jnp.sin(ang)


def rope2d(x, cos, sin):
    xr = x.astype(jnp.float32).reshape(x.shape[:-1] + (QK_ROPE_DIM // 2, 2))
    x0, x1 = xr[..., 0], xr[..., 1]
    out = jnp.stack([x0 * cos - x1 * sin, x0 * sin + x1 * cos], axis=-1)
    return out.reshape(x.shape).astype(x.dtype)


def mla_queries(p, q_norm_g, w_uq):
    q_c = rms_norm(p[..., :Q_LORA_RANK], q_norm_g)
    q = jnp.einsum('blr,rhe->blhe', q_c, w_uq)
    return q[..., :QK_NOPE_DIM], q[..., QK_NOPE_DIM:]


def mla_keys(p, kv_norm_g, w_uk, w_uv):
    kv_c = rms_norm(p[..., Q_LORA_RANK:KV_END], kv_norm_g)
    k_rope = p[..., KV_END:ROPE_END]
    k_nope = jnp.einsum('blr,rhe->blhe', kv_c, w_uk)
    v = jnp.einsum('blr,rhe->blhe', kv_c, w_uv)
    return k_nope, k_rope, v


def block_attention(q_nope, q_rope, k_nope, k_rope, v):
    b, lq = q_nope.shape[:2]
    nb = lq // Q_BLOCK
    scale = (QK_NOPE_DIM + QK_ROPE_DIM) ** -0.5

    def blocks(t):
        return jnp.moveaxis(t.reshape((b, nb, Q_BLOCK) + t.shape[2:]), 1, 0)

    def one_block(qs):
        qn, qr = qs
        s = jnp.einsum('bqhe,bkhe->bhqk', qn, k_nope) + jnp.einsum('bqhe,bke->bhqk', qr, k_rope)
        p = jax.nn.softmax(s.astype(jnp.float32) * scale, axis=-1).astype(v.dtype)
        return jnp.einsum('bhqk,bkhe->bqhe', p, v)

    o = lax.map(one_block, (blocks(q_nope), blocks(q_rope)))
    return jnp.moveaxis(o, 0, 1).reshape(b, lq, MLA_WIDTH)


def s5_discretise(lam_re, lam_im, log_dt, b_re, b_im):
    lam_re, lam_im = lam_re.astype(jnp.float32), lam_im.astype(jnp.float32)
    b_re, b_im = b_re.astype(jnp.float32), b_im.astype(jnp.float32)
    dt = jnp.exp(log_dt.astype(jnp.float32))[:, None]
    mag = jnp.exp(lam_re * dt)
    a_re, a_im = mag * jnp.cos(lam_im * dt), mag * jnp.sin(lam_im * dt)
    den = lam_re * lam_re + lam_im * lam_im
    f_re = ((a_re - 1) * lam_re + a_im * lam_im) / den
    f_im = (a_im * lam_re - (a_re - 1) * lam_im) / den
    bb_re = f_re[..., None] * b_re - f_im[..., None] * b_im
    bb_im = f_re[..., None] * b_im + f_im[..., None] * b_re
    return a_re, a_im, bb_re, bb_im


def complex_affine_combine(e1, e2):
    a1r, a1i, b1r, b1i = e1
    a2r, a2i, b2r, b2i = e2
    return (a2r * a1r - a2i * a1i,
            a2r * a1i + a2i * a1r,
            a2r * b1r - a2i * b1i + b2r,
            a2r * b1i + a2i * b1r + b2i)


def s5_states(u, a_re, a_im, bb_re, bb_im, reverse, h0=None):
    if reverse:
        u = jnp.flip(u, 0)
    bu_re = jnp.einsum('lbgc,gpc->lbgp', u, bb_re)
    bu_im = jnp.einsum('lbgc,gpc->lbgp', u, bb_im)
    if h0 is not None:
        bu_re = bu_re.at[0].add(a_re * h0[0] - a_im * h0[1])
        bu_im = bu_im.at[0].add(a_re * h0[1] + a_im * h0[0])
    n = u.shape[0]
    a_seq_re = jnp.broadcast_to(a_re, (n, 1) + a_re.shape)
    a_seq_im = jnp.broadcast_to(a_im, (n, 1) + a_im.shape)
    _, _, h_re, h_im = lax.associative_scan(complex_affine_combine, (a_seq_re, a_seq_im, bu_re, bu_im), axis=0)
    if reverse:
        h_re, h_im = jnp.flip(h_re, 0), jnp.flip(h_im, 0)
    return h_re, h_im


def s5_readout(h, c_re, c_im):
    h_re, h_im = h
    return (jnp.einsum('lbgp,gcp->lbgc', h_re, c_re.astype(jnp.float32))
            - jnp.einsum('lbgp,gcp->lbgc', h_im, c_im.astype(jnp.float32)))


def s5_glu(y, w_glu, b_glu):
    l, b = y.shape[:2]
    y = jnp.swapaxes(y.reshape(l, b, S5_WIDTH), 0, 1)
    z = jax.nn.gelu(y)
    return z * jax.nn.sigmoid(z @ w_glu.astype(jnp.float32) + b_glu.astype(jnp.float32))


def to_groups(u):
    return jnp.swapaxes(u, 0, 1).reshape(u.shape[1], u.shape[0], S5_GROUPS, S5_GROUP).astype(jnp.float32)


def s5_mixer(u_lat, u_ctx, lp, with_ctx_out):
    ul, uc = to_groups(u_lat), to_groups(u_ctx)
    d = lp['s5_d'].astype(jnp.float32).reshape(S5_GROUPS, S5_GROUP)
    y_lat = ul * d
    y_ctx = uc * d if with_ctx_out else None
    for direction, reverse in ((0, False), (1, True)):
        a_re, a_im, bb_re, bb_im = s5_discretise(lp['s5_lambda_re'][direction], lp['s5_lambda_im'][direction],
                                                 lp['s5_log_dt'][direction], lp['s5_b_re'][direction],
                                                 lp['s5_b_im'][direction])
        h_ctx = s5_states(uc, a_re, a_im, bb_re, bb_im, reverse)
        edge = 0 if reverse else -1
        h_lat = s5_states(ul, a_re, a_im, bb_re, bb_im, reverse, h0=(h_ctx[0][edge], h_ctx[1][edge]))
        y_lat = y_lat + s5_readout(h_lat, lp['s5_c_re'][direction], lp['s5_c_im'][direction])
        if with_ctx_out:
            y_ctx = y_ctx + s5_readout(h_ctx, lp['s5_c_re'][direction], lp['s5_c_im'][direction])
    out_lat = s5_glu(y_lat, lp['s5_w_glu'], lp['s5_b_glu']).astype(u_lat.dtype)
    out_ctx = s5_glu(y_ctx, lp['s5_w_glu'], lp['s5_b_glu']).astype(u_ctx.dtype) if with_ctx_out else None
    return out_lat, out_ctx


def mixer_sublayer(u_lat, u_ctx, lp, cos, sin, with_ctx_out):
    p_lat = u_lat @ lp['w_in']
    p_ctx = u_ctx @ lp['w_in']
    qn, qr = mla_queries(p_lat, lp['q_norm_g'], lp['w_uq'])
    qr = rope2d(qr, cos[:, None, :], sin[:, None, :])
    kn, kr, v = mla_keys(p_lat, lp['kv_norm_g'], lp['w_uk'], lp['w_uv'])
    kr = rope2d(kr, cos, sin)
    kn_c, kr_c, v_c = mla_keys(p_ctx, lp['kv_norm_g'], lp['w_uk'], lp['w_uv'])
    att_lat = block_attention(qn, qr, jnp.concatenate([kn_c, kn], 1), jnp.concatenate([kr_c, kr], 1),
                              jnp.concatenate([v_c, v], 1))
    s5_lat, s5_ctx = s5_mixer(p_lat[..., ROPE_END:], p_ctx[..., ROPE_END:], lp, with_ctx_out)
    y_lat = jnp.concatenate([att_lat, s5_lat], axis=-1) @ lp['w_out']
    y_ctx = None
    if with_ctx_out:
        qn_c, qr_c = mla_queries(p_ctx, lp['q_norm_g'], lp['w_uq'])
        att_ctx = block_attention(qn_c, qr_c, kn_c, kr_c, v_c)
        y_ctx = jnp.concatenate([att_ctx, s5_ctx], axis=-1) @ lp['w_out']
    return y_lat, y_ctx


def swiglu(u, w_gate_up, w_down):
    gate, up = jnp.split(u @ w_gate_up, 2, axis=-1)
    return (jax.nn.silu(gate) * up) @ w_down


def trunk_layer(x, ctx, mod_lat, mod_ctx, lp, cos, sin, with_ctx_out):
    sh1, sc1, g1, sh2, sc2, g2 = mod_lat
    csh1, csc1, cg1, csh2, csc2, cg2 = mod_ctx
    y_lat, y_ctx = mixer_sublayer(modulate(x, sh1, sc1), modulate(ctx, csh1, csc1), lp, cos, sin, with_ctx_out)
    x = layer_norm(DN_ALPHA * x + g1 * y_lat, lp['ln1_g'], lp['ln1_b'])
    x = layer_norm(DN_ALPHA * x + g2 * swiglu(modulate(x, sh2, sc2), lp['w_gate_up'], lp['w_down']),
                   lp['ln2_g'], lp['ln2_b'])
    if with_ctx_out:
        ctx = layer_norm(DN_ALPHA * ctx + cg1 * y_ctx, lp['ln1_g'], lp['ln1_b'])
        ctx = layer_norm(DN_ALPHA * ctx + cg2 * swiglu(modulate(ctx, csh2, csc2), lp['w_gate_up'], lp['w_down']),
                         lp['ln2_g'], lp['ln2_b'])
    return x, ctx


def setup_inputs(seed: int = 0) -> dict:
    key = jax.random.key(seed)
    ks = iter(jax.random.split(key, 29))
    f32 = jnp.float32

    def nrm(shape, scale):
        return jax.random.normal(next(ks), shape, f32) * scale

    lam_re = -0.5 + nrm((DEPTH, 2, S5_GROUPS, S5_STATE), 0.01)
    lam_im = jnp.pi * jnp.arange(S5_STATE, dtype=f32) + nrm((DEPTH, 2, S5_GROUPS, S5_STATE), 0.01)
    return {
        'x': nrm((BATCH, SEQ, D_MODEL), 1.0),
        'c': nrm((BATCH, D_MODEL), 1.0),
        'ctx': nrm((BATCH, CTX_LEN, D_MODEL), 1.0),
        'c_ctx': nrm((D_MODEL,), 1.0),
        'w_ada': nrm((DEPTH, D_MODEL, 6 * D_MODEL), D_MODEL ** -0.5),
        'b_ada': nrm((DEPTH, 6 * D_MODEL), 0.02),
        'w_in': nrm((DEPTH, D_MODEL, D_IN), D_MODEL ** -0.5),
        'q_norm_g': 1.0 + nrm((DEPTH, Q_LORA_RANK), 0.02),
        'kv_norm_g': 1.0 + nrm((DEPTH, KV_LORA_RANK), 0.02),
        'w_uq': nrm((DEPTH, Q_LORA_RANK, N_MLA_HEADS, QK_NOPE_DIM + QK_ROPE_DIM), Q_LORA_RANK ** -0.5),
        'w_uk': nrm((DEPTH, KV_LORA_RANK, N_MLA_HEADS, QK_NOPE_DIM), KV_LORA_RANK ** -0.5),
        'w_uv': nrm((DEPTH, KV_LORA_RANK, N_MLA_HEADS, V_HEAD_DIM), KV_LORA_RANK ** -0.5 * DN_BETA),
        's5_lambda_re': lam_re,
        's5_lambda_im': lam_im,
        's5_log_dt': jax.random.uniform(next(ks), (DEPTH, 2, S5_GROUPS), f32,
                                        minval=math.log(DT_MIN), maxval=math.log(DT_MAX)),
        's5_b_re': nrm((DEPTH, 2, S5_GROUPS, S5_STATE, S5_GROUP), (2 * S5_GROUP) ** -0.5),
        's5_b_im': nrm((DEPTH, 2, S5_GROUPS, S5_STATE, S5_GROUP), (2 * S5_GROUP) ** -0.5),
        's5_c_re': nrm((DEPTH, 2, S5_GROUPS, S5_GROUP, S5_STATE), (2 * S5_STATE) ** -0.5),
        's5_c_im': nrm((DEPTH, 2, S5_GROUPS, S5_GROUP, S5_STATE), (2 * S5_STATE) ** -0.5),
        's5_d': nrm((DEPTH, S5_WIDTH), 1.0),
        's5_w_glu': nrm((DEPTH, S5_WIDTH, S5_WIDTH), S5_WIDTH ** -0.5),
        's5_b_glu': nrm((DEPTH, S5_WIDTH), 0.02),
        'w_out': nrm((DEPTH, D_MODEL, D_MODEL), D_MODEL ** -0.5 * DN_BETA),
        'ln1_g': 1.0 + nrm((DEPTH, D_MODEL), 0.02),
        'ln1_b': nrm((DEPTH, D_MODEL), 0.02),
        'w_gate_up': nrm((DEPTH, D_MODEL, 2 * D_FF), D_MODEL ** -0.5),
        'w_down': nrm((DEPTH, D_FF, D_MODEL), D_FF ** -0.5 * DN_BETA),
        'ln2_g': 1.0 + nrm((DEPTH, D_MODEL), 0.02),
        'ln2_b': nrm((DEPTH, D_MODEL), 0.02),
    }


def reference(x, c, ctx, c_ctx, w_ada, b_ada, w_in, q_norm_g, kv_norm_g, w_uq, w_uk, w_uv,
              s5_lambda_re, s5_lambda_im, s5_log_dt, s5_b_re, s5_b_im, s5_c_re, s5_c_im, s5_d,
              s5_w_glu, s5_b_glu, w_out, ln1_g, ln1_b, w_gate_up, w_down, ln2_g, ln2_b):
    ROWS = x.shape[1] // GRID_W
    cos, sin = axial_rope(ROWS)
    for i in range(DEPTH):
        lp = dict(w_in=w_in[i], q_norm_g=q_norm_g[i], kv_norm_g=kv_norm_g[i], w_uq=w_uq[i], w_uk=w_uk[i],
                  w_uv=w_uv[i], s5_lambda_re=s5_lambda_re[i], s5_lambda_im=s5_lambda_im[i],
                  s5_log_dt=s5_log_dt[i], s5_b_re=s5_b_re[i], s5_b_im=s5_b_im[i], s5_c_re=s5_c_re[i],
                  s5_c_im=s5_c_im[i], s5_d=s5_d[i], s5_w_glu=s5_w_glu[i], s5_b_glu=s5_b_glu[i],
                  w_out=w_out[i], ln1_g=ln1_g[i], ln1_b=ln1_b[i], w_gate_up=w_gate_up[i],
                  w_down=w_down[i], ln2_g=ln2_g[i], ln2_b=ln2_b[i])
        mod_lat = adaln(c[:, None, :], w_ada[i], b_ada[i])
        mod_ctx = adaln(c_ctx, w_ada[i], b_ada[i])
        x, ctx = trunk_layer(x, ctx, mod_lat, mod_ctx, lp, cos, sin, with_ctx_out=(i < DEPTH - 1))
    return x
```

```cpp
#include <hip/hip_runtime.h>
#include <hip/hip_cooperative_groups.h>
#include <hip/hip_bf16.h>
#include <cstdio>
#include <cstdint>
#include <cmath>
namespace cg = cooperative_groups;

namespace pg8 {
#define PG8_LAS __attribute__((address_space(3)))
typedef unsigned short bf16_t;
typedef short bf16x8 __attribute__((ext_vector_type(8)));
typedef float f32x4 __attribute__((ext_vector_type(4)));
typedef float f32x2 __attribute__((ext_vector_type(2)));
typedef unsigned u32x4 __attribute__((ext_vector_type(4)));
constexpr int BM = 256, BK = 64, HALF = 128, HTB = HALF * BK * 2, STAGE_BYTES = 8 * HTB, NXCD = 8, WGM = 8;

__host__ __device__ __forceinline__ int lds_byte(int r, int c) { const int st = (r >> 4) * 2 + (c >> 5), rr = r & 15, cc = c & 31, ob = rr * 64 + cc * 2; return st * 1024 + (ob ^ (((ob >> 9) & 1) << 5)); }
__host__ __device__ __forceinline__ void stage_rc(int b, int& R, int& C) { const int st = b / 1024, sb = b % 1024, swz = sb ^ (((sb >> 9) & 1) << 5); R = (st >> 1) * 16 + swz / 64; C = (st & 1) * 32 + (swz % 64) / 2; }
__host__ __device__ __forceinline__ int perm32(int rho) { const int n = rho >> 4, i = rho & 15; return 8 * (i >> 2) + 4 * n + (i & 3); }

struct Unit { int pm, pn; };
struct Gemm { const bf16_t* A; const bf16_t* Bt; int K, lda, ldb; };

struct StaticOrder {
    int nM, nN, nwg, G, c;
    __device__ void init(int M, int N, int G_, int c_) { nM = M / BM; nN = N / BM; nwg = nM * nN; G = G_; c = c_; }
    __device__ bool next(int i, Unit& u) const {
        const long L = (long)i * G + c; if (L >= nwg) return false;
        int wgid = (int)L; { const int q = nwg / NXCD, r = nwg % NXCD, xcd = wgid % NXCD, off = wgid / NXCD; wgid = (xcd < r ? xcd * (q + 1) : r * (q + 1) + (xcd - r) * q) + off; }
        const int nig = WGM * nN, gid = wgid / nig, fm = gid * WGM, gsz = (nM - fm) < WGM ? (nM - fm) : WGM;
        u.pm = fm + ((wgid % nig) % gsz); u.pn = (wgid % nig) / gsz; return true;
    }
};

__device__ __forceinline__ unsigned cvt_pk_bf16(float lo, float hi) { unsigned r; asm volatile("v_cvt_pk_bf16_f32 %0, %1, %2" : "=v"(r) : "v"(lo), "v"(hi)); return r; }
__device__ __forceinline__ u32x4 pack8(f32x4 v0, f32x4 v1) { u32x4 w; w.x = cvt_pk_bf16(v0[0], v0[1]); w.y = cvt_pk_bf16(v0[2], v0[3]); w.z = cvt_pk_bf16(v1[0], v1[1]); w.w = cvt_pk_bf16(v1[2], v1[3]); return w; }

template <class Epi, class Sched, bool ALIGN_EPI>
__device__ __forceinline__ void gemm_phase(PG8_LAS unsigned char* lds, const Gemm g, const Sched& S, const Epi& E) {
    int tid_ = threadIdx.x; asm volatile("" : "+v"(tid_));
    const int tid = tid_, wid = __builtin_amdgcn_readfirstlane(tid >> 6), lane = tid & 63, wr = wid >> 2, wc = wid & 3, fr = lane & 15, fq = lane >> 4;
    int K_ = g.K; asm volatile("" : "+s"(K_));
    const int K = K_, nt = K / BK;
    unsigned voffA[2], voffB[2];
#pragma unroll
    for (int i = 0; i < 2; ++i) { int R, C; stage_rc(tid * 16 + i * 8192, R, C); const int Rb = Epi::PERM ? ((R & ~31) + perm32(R & 31)) : R;
        voffA[i] = (unsigned)(R * g.lda + C) * 2u; voffB[i] = (unsigned)(Rb * g.ldb + C) * 2u; }
    const size_t kstep = (size_t)(BK * 2);
    const size_t hstepA = (size_t)HALF * g.lda * 2, hstepB = (size_t)HALF * g.ldb * 2;
    const size_t tstepA = 2 * hstepA, tstepB = 2 * hstepB;
    const unsigned ldsw = (unsigned)wid * 1024u;
    const int aoff = lds_byte(wr * 64 + fr, fq * 8), boff = lds_byte(wc * 32 + fr, fq * 8);
#define PG8_SA(b, h) (((b) * 2 + (h)) * HTB)
#define PG8_SB(b, h) ((4 + (b) * 2 + (h)) * HTB)
#define PG8_STAGE(bufoff, gbase, voff) do { _Pragma("unroll") for (int _i = 0; _i < 2; ++_i) \
        __builtin_amdgcn_global_load_lds((const unsigned*)((const char*)(gbase) + (voff)[_i]), (PG8_LAS unsigned*)(lds + (bufoff) + ldsw + _i * 8192), 16, 0, 0); } while (0)
#define PG8_LDA(dst, b, h) do { _Pragma("unroll") for (int m = 0; m < 4; ++m) _Pragma("unroll") for (int k = 0; k < 2; ++k) dst[m][k] = *(const PG8_LAS bf16x8*)(lds + PG8_SA(b, h) + aoff + m * 2048 + k * 1024); } while (0)
#define PG8_LDB(dst, b, h) do { _Pragma("unroll") for (int n = 0; n < 2; ++n) _Pragma("unroll") for (int k = 0; k < 2; ++k) dst[n][k] = *(const PG8_LAS bf16x8*)(lds + PG8_SB(b, h) + boff + n * 2048 + k * 1024); } while (0)
#define PG8_MMA(ai, bj, At, Bt) do { __builtin_amdgcn_s_setprio(1); _Pragma("unroll") for (int m = 0; m < 4; ++m) _Pragma("unroll") for (int n = 0; n < 2; ++n) _Pragma("unroll") for (int k = 0; k < 2; ++k) \
        acc[ai][bj][m][n] = __builtin_amdgcn_mfma_f32_16x16x32_bf16(Bt[n][k], At[m][k], acc[ai][bj][m][n], 0, 0, 0); __builtin_amdgcn_s_setprio(0); } while (0)
#define PG8_WAIT_V(n) asm volatile("s_waitcnt vmcnt(" #n ")" ::: "memory")
#define PG8_WAIT_L(n) asm volatile("s_waitcnt lgkmcnt(" #n ")" ::: "memory")
#define PG8_BAR __builtin_amdgcn_s_barrier()
#define PG8_SCHED __builtin_amdgcn_sched_barrier(0)
    Unit cur, nxt; int ui = 0;
    if (!S.next(0, cur)) return;
    f32x4 acc[2][2][4][2];
#pragma unroll
    for (int a = 0; a < 2; ++a)
#pragma unroll
        for (int b = 0; b < 2; ++b)
#pragma unroll
            for (int m = 0; m < 4; ++m)
#pragma unroll
                for (int n = 0; n < 2; ++n) acc[a][b][m][n] = (f32x4){0.f, 0.f, 0.f, 0.f};
    bf16x8 At[4][2], B0[2][2], B1[2][2];
    const char* cA = (const char*)g.A + (size_t)cur.pm * tstepA; const char* cB = (const char*)g.Bt + (size_t)cur.pn * tstepB;
    PG8_STAGE(PG8_SB(0, 0), cB, voffB); PG8_STAGE(PG8_SB(0, 1), cB + hstepB, voffB); PG8_STAGE(PG8_SA(0, 0), cA, voffA); PG8_STAGE(PG8_SA(0, 1), cA + hstepA, voffA);
    if (wr == 1) PG8_BAR;
    PG8_WAIT_V(2); PG8_BAR;
    PG8_STAGE(PG8_SB(1, 0), cB + kstep, voffB); PG8_STAGE(PG8_SA(1, 0), cA + kstep, voffA); PG8_STAGE(PG8_SB(1, 1), cB + hstepB + kstep, voffB);
    PG8_WAIT_V(6); PG8_BAR;
    for (;;) {
        const bool has_next = S.next(ui + 1, nxt);
        const char* nA = has_next ? (const char*)g.A + (size_t)nxt.pm * tstepA : cA; const char* nB = has_next ? (const char*)g.Bt + (size_t)nxt.pn * tstepB : cB;
        for (int t = 0; t < nt; t += 2) {
            const bool last = (t == nt - 2);
            const char* a1 = cA + (size_t)(t + 1) * kstep;
            const char* a2 = last ? nA : cA + (size_t)(t + 2) * kstep; const char* b2 = last ? nB : cB + (size_t)(t + 2) * kstep;
            const char* a3 = a2 + kstep; const char* b3 = b2 + kstep;
            PG8_LDB(B0, 0, 0); PG8_LDB(B1, 0, 1); PG8_SCHED; PG8_LDA(At, 0, 0); PG8_STAGE(PG8_SA(1, 1), a1 + hstepA, voffA);
            PG8_WAIT_V(8); PG8_WAIT_L(0); PG8_BAR; PG8_MMA(0, 0, At, B0); PG8_MMA(0, 1, At, B1); PG8_BAR; PG8_SCHED;
            PG8_LDA(At, 0, 1); PG8_STAGE(PG8_SB(0, 0), b2, voffB); PG8_STAGE(PG8_SB(0, 1), b2 + hstepB, voffB); PG8_STAGE(PG8_SA(0, 0), a2, voffA);
            PG8_WAIT_V(8); PG8_WAIT_L(0); PG8_BAR; PG8_MMA(1, 0, At, B0); PG8_MMA(1, 1, At, B1); PG8_BAR; PG8_SCHED;
            PG8_LDB(B0, 1, 0); PG8_LDB(B1, 1, 1); PG8_SCHED; PG8_LDA(At, 1, 0); PG8_STAGE(PG8_SA(0, 1), a2 + hstepA, voffA);
            PG8_WAIT_V(8); PG8_WAIT_L(0); PG8_BAR; PG8_MMA(0, 0, At, B0); PG8_MMA(0, 1, At, B1); PG8_BAR; PG8_SCHED;
            PG8_LDA(At, 1, 1); PG8_STAGE(PG8_SB(1, 0), b3, voffB); PG8_STAGE(PG8_SB(1, 1), b3 + hstepB, voffB); PG8_STAGE(PG8_SA(1, 0), a3, voffA);
            PG8_WAIT_V(8); PG8_WAIT_L(0); PG8_BAR; PG8_MMA(1, 0, At, B0); PG8_MMA(1, 1, At, B1); PG8_BAR; PG8_SCHED;
        }
        if constexpr (ALIGN_EPI) { if (wr == 0) PG8_BAR; }
        E(acc, cur, wr, wc, fr, fq);
        if (!has_next) break;
#pragma unroll
        for (int a = 0; a < 2; ++a)
#pragma unroll
            for (int b = 0; b < 2; ++b)
#pragma unroll
                for (int m = 0; m < 4; ++m)
#pragma unroll
                    for (int n = 0; n < 2; ++n) acc[a][b][m][n] = (f32x4){0.f, 0.f, 0.f, 0.f};
        cur = nxt; cA = nA; cB = nB; ++ui;
        if constexpr (ALIGN_EPI) { if (wr == 1) PG8_BAR; }
    }
    PG8_WAIT_V(0);
    if constexpr (!ALIGN_EPI) { if (wr == 0) PG8_BAR; }
    PG8_BAR;
#undef PG8_SA
#undef PG8_SB
#undef PG8_STAGE
#undef PG8_LDA
#undef PG8_LDB
#undef PG8_MMA
#undef PG8_WAIT_V
#undef PG8_WAIT_L
#undef PG8_BAR
#undef PG8_SCHED
}
}

using pg8::bf16_t; using pg8::f32x4; using pg8::u32x4; using pg8::Unit; using pg8::pack8;
typedef float f32x2v __attribute__((ext_vector_type(2)));

constexpr int DM = 1024, NB = 8, SEQ = 4096, CTXL = 256, NH = 8, LK = SEQ + CTXL;
constexpr int MLAT = NB * SEQ, MCTX = NB * CTXL, MALL = MLAT + MCTX;
constexpr int QLR = 384, KVLR = 256, DIN = 1184, DFF = 2816;
constexpr int S5G = 32, S5P = 64, S5T = 32, NCH = 1280;
constexpr float EPS = 1e-6f;
constexpr float DN_ALPHA = 1.189207115002721f;

constexpr size_t MiB = 1u << 20;
constexpr size_t WS_MODS = 1 * MiB, WS_ROPE = 2 * MiB, WS_AP = 3 * MiB, WS_BBAR = 5 * MiB, WS_KT = 6 * MiB, WS_SS = 8 * MiB;
constexpr size_t WS_WIN = 12 * MiB, WS_WUQ = 15 * MiB, WS_WKV = 16 * MiB, WS_WGLU = 17 * MiB, WS_WOUT = 18 * MiB, WS_WGU = 20 * MiB, WS_WDN = 31 * MiB;
constexpr size_t WS_FM = 37 * MiB, WS_ME = 45 * MiB, WS_XN = 70 * MiB;
constexpr size_t WS_H = 138 * MiB, WS_PQ = 138 * MiB, WS_PKV = 162 * MiB, WS_A2 = 179 * MiB, WS_LB = 239 * MiB, WS_Q = 279 * MiB, WS_K = 327 * MiB, WS_V = 378 * MiB, WS_Z = 412 * MiB, WS_CAT = 444 * MiB, WS_END = 508 * MiB;

struct Params {
    const float* in[29];
    float* out; unsigned char* ws;
};

struct EpiIn {
    static constexpr bool PERM = true;
    bf16_t* PQ; bf16_t* PKV; float* SS; bf16_t* Kb; bf16_t* A2; const f32x2v* rope;
    __device__ __forceinline__ void operator()(const f32x4 (&acc)[2][2][4][2], const Unit& u, int wr, int wc, int fr, int fq) const {
#pragma unroll
        for (int ai = 0; ai < 2; ++ai)
#pragma unroll
            for (int m = 0; m < 4; ++m) {
                const int row = u.pm * 256 + ai * 128 + wr * 64 + m * 16 + fr;
                const bool lat = row < MLAT;
                const int b = lat ? (row >> 12) : ((row - MLAT) >> 8), l = lat ? (row & 4095) : ((row - MLAT) & 255);
#pragma unroll
                for (int bj = 0; bj < 2; ++bj) {
                    const int cseg = u.pn * 256 + bj * 128 + wc * 32, c0 = cseg + 8 * fq;
                    const f32x4 v0 = acc[ai][bj][m][0], v1 = acc[ai][bj][m][1];
                    if (cseg < 640) {
                        float ss = (v0[0] * v0[0] + v0[1] * v0[1]) + (v0[2] * v0[2] + v0[3] * v0[3]) + (v1[0] * v1[0] + v1[1] * v1[1]) + (v1[2] * v1[2] + v1[3] * v1[3]);
                        ss += __shfl_xor(ss, 16); ss += __shfl_xor(ss, 32);
                        if (fq == 0) SS[(size_t)row * 20 + (cseg >> 5)] = ss;
                        const u32x4 w = pack8(v0, v1);
                        if (cseg < QLR) { if (lat) *(u32x4*)(PQ + (size_t)row * QLR + c0) = w; }
                        else *(u32x4*)(PKV + (size_t)row * KVLR + (c0 - QLR)) = w;
                    } else if (cseg < 672) {
                        f32x4 o0 = v0, o1 = v1;
                        if (lat) {
                            const f32x2v* rp = rope + (size_t)l * 16 + 4 * fq;
                            const f32x2v c0_ = rp[0], c1_ = rp[1], c2_ = rp[2], c3_ = rp[3];
                            o0[0] = v0[0] * c0_.x - v0[1] * c0_.y; o0[1] = v0[0] * c0_.y + v0[1] * c0_.x;
                            o0[2] = v0[2] * c1_.x - v0[3] * c1_.y; o0[3] = v0[2] * c1_.y + v0[3] * c1_.x;
                            o1[0] = v1[0] * c2_.x - v1[1] * c2_.y; o1[1] = v1[0] * c2_.y + v1[1] * c2_.x;
                            o1[2] = v1[2] * c3_.x - v1[3] * c3_.y; o1[3] = v1[2] * c3_.y + v1[3] * c3_.x;
                        }
                        const int key = lat ? CTXL + l : l;
                        const u32x4 w = pack8(o0, o1);
#pragma unroll
                        for (int h = 0; h < NH; ++h) *(u32x4*)(Kb + ((size_t)(b * NH + h) * LK + key) * 96 + 64 + 8 * fq) = w;
                    } else if (cseg < DIN) {
                        const int cu = c0 - 672, g = cu >> 4, c = cu & 15;
                        const int n = lat ? b * 128 + (l >> 5) : 1024 + b * 8 + (l >> 5), j = l & 31;
                        *(u32x4*)(A2 + ((size_t)g * NCH + n) * 768 + j * 16 + c) = pack8(v0, v1);
                    }
                }
                asm volatile("" ::: "memory"); __builtin_amdgcn_sched_barrier(0);
            }
    }
};

struct EpiQ {
    static constexpr bool PERM = true;
    bf16_t* Q; const float* SS; const f32x2v* rope;
    __device__ __forceinline__ void operator()(const f32x4 (&acc)[2][2][4][2], const Unit& u, int wr, int wc, int fr, int fq) const {
#pragma unroll
        for (int ai = 0; ai < 2; ++ai)
#pragma unroll
            for (int m = 0; m < 4; ++m) {
                const int row = u.pm * 256 + ai * 128 + wr * 64 + m * 16 + fr, b = row >> 12, l = row & 4095;
                const f32x4* sp = (const f32x4*)(SS + (size_t)row * 20);
                const f32x4 s0 = sp[0], s1 = sp[1], s2 = sp[2];
                const float sum = ((s0[0] + s0[1]) + (s0[2] + s0[3])) + ((s1[0] + s1[1]) + (s1[2] + s1[3])) + ((s2[0] + s2[1]) + (s2[2] + s2[3]));
                const float rs = 1.0f / sqrtf(sum * (1.0f / QLR) + EPS);
#pragma unroll
                for (int bj = 0; bj < 2; ++bj) {
                    const int c0 = u.pn * 256 + bj * 128 + wc * 32 + 8 * fq, h = c0 / 96, e = c0 - h * 96;
                    f32x4 v0 = acc[ai][bj][m][0] * rs, v1 = acc[ai][bj][m][1] * rs;
                    if (e >= 64) {
                        const f32x2v* rp = rope + (size_t)l * 16 + ((e - 64) >> 1);
                        const f32x2v c0_ = rp[0], c1_ = rp[1], c2_ = rp[2], c3_ = rp[3];
                        f32x4 o0, o1;
                        o0[0] = v0[0] * c0_.x - v0[1] * c0_.y; o0[1] = v0[0] * c0_.y + v0[1] * c0_.x;
                        o0[2] = v0[2] * c1_.x - v0[3] * c1_.y; o0[3] = v0[2] * c1_.y + v0[3] * c1_.x;
                        o1[0] = v1[0] * c2_.x - v1[1] * c2_.y; o1[1] = v1[0] * c2_.y + v1[1] * c2_.x;
                        o1[2] = v1[2] * c3_.x - v1[3] * c3_.y; o1[3] = v1[2] * c3_.y + v1[3] * c3_.x;
                        v0 = o0; v1 = o1;
                    }
                    *(u32x4*)(Q + ((size_t)(b * NH + h) * SEQ + l) * 96 + e) = pack8(v0, v1);
                }
                asm volatile("" ::: "memory"); __builtin_amdgcn_sched_barrier(0);
            }
    }
};

struct EpiKV {
    static constexpr bool PERM = true;
    bf16_t* Kb; bf16_t* Vb; const float* SS;
    __device__ __forceinline__ void operator()(const f32x4 (&acc)[2][2][4][2], const Unit& u, int wr, int wc, int fr, int fq) const {
#pragma unroll
        for (int ai = 0; ai < 2; ++ai)
#pragma unroll
            for (int m = 0; m < 4; ++m) {
                const int row = u.pm * 256 + ai * 128 + wr * 64 + m * 16 + fr;
                const bool lat = row < MLAT;
                const int b = lat ? (row >> 12) : ((row - MLAT) >> 8), l = lat ? (row & 4095) : ((row - MLAT) & 255);
                const int key = lat ? CTXL + l : l;
                const f32x4* sp = (const f32x4*)(SS + (size_t)row * 20 + 12);
                const f32x4 s0 = sp[0], s1 = sp[1];
                const float sum = ((s0[0] + s0[1]) + (s0[2] + s0[3])) + ((s1[0] + s1[1]) + (s1[2] + s1[3]));
                const float rs = 1.0f / sqrtf(sum * (1.0f / KVLR) + EPS);
#pragma unroll
                for (int bj = 0; bj < 2; ++bj) {
                    const int c0 = u.pn * 256 + bj * 128 + wc * 32 + 8 * fq;
                    const u32x4 w = pack8(acc[ai][bj][m][0] * rs, acc[ai][bj][m][1] * rs);
                    if (c0 < 512) { const int h = c0 >> 6, e = c0 & 63; *(u32x4*)(Kb + ((size_t)(b * NH + h) * LK + key) * 96 + e) = w; }
                    else { const int c1 = c0 - 512, h = c1 >> 6, e = c1 & 63; *(u32x4*)(Vb + ((size_t)(b * NH + h) * LK + key) * 64 + e) = w; }
                }
                asm volatile("" ::: "memory"); __builtin_amdgcn_sched_barrier(0);
            }
    }
};

struct EpiS1 {
    static constexpr bool PERM = true;
    float* Lb;
    __device__ __forceinline__ void operator()(const f32x4 (&acc)[2][2][4][2], const Unit& u, int wr, int wc, int fr, int fq) const {
#pragma unroll
        for (int ai = 0; ai < 2; ++ai)
#pragma unroll
            for (int m = 0; m < 4; ++m) {
                const int row = u.pm * 256 + ai * 128 + wr * 64 + m * 16 + fr;
#pragma unroll
                for (int bj = 0; bj < 2; ++bj) {
                    float* p = Lb + (size_t)row * 256 + bj * 128 + wc * 32 + 8 * fq;
                    *(f32x4*)p = acc[ai][bj][m][0]; *(f32x4*)(p + 4) = acc[ai][bj][m][1];
                }
            }
    }
};

__device__ __forceinline__ float gelu_tanh(float x) { const float t = 1.5957691216057308f * (x + 0.044715f * x * x * x); return x / (1.0f + __expf(-t)); }
__device__ __forceinline__ float sigmoidf_(float x) { return 1.0f / (1.0f + __expf(-x)); }

struct EpiS2 {
    static constexpr bool PERM = true;
    bf16_t* Z;
    __device__ __forceinline__ void operator()(const f32x4 (&acc)[2][2][4][2], const Unit& u, int wr, int wc, int fr, int fq) const {
        const int g = u.pn >> 1, jn = u.pn & 1, it = u.pm - g * 5;
#pragma unroll
        for (int ai = 0; ai < 2; ++ai)
#pragma unroll
            for (int m = 0; m < 4; ++m) {
                const int n = it * 256 + ai * 128 + wr * 64 + m * 16 + fr, b = n >> 7, j = n & 127;
#pragma unroll
                for (int bj = 0; bj < 2; ++bj) {
                    const int cc = jn * 256 + bj * 128 + wc * 32 + 8 * fq, ti = cc >> 4, c = cc & 15;
                    f32x4 v0 = acc[ai][bj][m][0], v1 = acc[ai][bj][m][1];
#pragma unroll
                    for (int k = 0; k < 4; ++k) { v0[k] = gelu_tanh(v0[k]); v1[k] = gelu_tanh(v1[k]); }
                    *(u32x4*)(Z + ((size_t)b * SEQ + j * 32 + ti) * 512 + g * 16 + c) = pack8(v0, v1);
                }
            }
    }
};

__device__ __forceinline__ float bf_lo(unsigned w) { return __uint_as_float(w << 16); }
__device__ __forceinline__ float bf_hi(unsigned w) { return __uint_as_float(w & 0xffff0000u); }

struct EpiGlu {
    static constexpr bool PERM = true;
    const bf16_t* Z; bf16_t* CAT; const float* bglu;
    __device__ __forceinline__ void operator()(const f32x4 (&acc)[2][2][4][2], const Unit& u, int wr, int wc, int fr, int fq) const {
#pragma unroll
        for (int ai = 0; ai < 2; ++ai)
#pragma unroll
            for (int m = 0; m < 4; ++m) {
                const int row = u.pm * 256 + ai * 128 + wr * 64 + m * 16 + fr;
#pragma unroll
                for (int bj = 0; bj < 2; ++bj) {
                    const int c0 = u.pn * 256 + bj * 128 + wc * 32 + 8 * fq;
                    const u32x4 zw = *(const u32x4*)(Z + (size_t)row * 512 + c0);
                    const f32x4 b0 = *(const f32x4*)(bglu + c0), b1 = *(const f32x4*)(bglu + c0 + 4);
                    const f32x4 a0 = acc[ai][bj][m][0] + b0, a1 = acc[ai][bj][m][1] + b1;
                    f32x4 o0, o1;
                    o0[0] = bf_lo(zw.x) * sigmoidf_(a0[0]); o0[1] = bf_hi(zw.x) * sigmoidf_(a0[1]); o0[2] = bf_lo(zw.y) * sigmoidf_(a0[2]); o0[3] = bf_hi(zw.y) * sigmoidf_(a0[3]);
                    o1[0] = bf_lo(zw.z) * sigmoidf_(a1[0]); o1[1] = bf_hi(zw.z) * sigmoidf_(a1[1]); o1[2] = bf_lo(zw.w) * sigmoidf_(a1[2]); o1[3] = bf_hi(zw.w) * sigmoidf_(a1[3]);
                    *(u32x4*)(CAT + (size_t)row * DM + 512 + c0) = pack8(o0, o1);
                }
                asm volatile("" ::: "memory"); __builtin_amdgcn_sched_barrier(0);
            }
    }
};

struct EpiRes {
    static constexpr bool PERM = true;
    const float* base; float* out; const float* gate;
    __device__ __forceinline__ void operator()(const f32x4 (&acc)[2][2][4][2], const Unit& u, int wr, int wc, int fr, int fq) const {
#pragma unroll
        for (int ai = 0; ai < 2; ++ai)
#pragma unroll
            for (int m = 0; m < 4; ++m) {
                const int row = u.pm * 256 + ai * 128 + wr * 64 + m * 16 + fr, b = row >> 12;
#pragma unroll
                for (int bj = 0; bj < 2; ++bj) {
                    const int c0 = u.pn * 256 + bj * 128 + wc * 32 + 8 * fq;
                    const float* gp = gate + (size_t)b * 6144 + c0; const float* bp = base + (size_t)row * DM + c0; float* op = out + (size_t)row * DM + c0;
                    const f32x4 g0 = *(const f32x4*)gp, g1 = *(const f32x4*)(gp + 4), x0 = *(const f32x4*)bp, x1 = *(const f32x4*)(bp + 4);
                    *(f32x4*)op = x0 * DN_ALPHA + g0 * acc[ai][bj][m][0]; *(f32x4*)(op + 4) = x1 * DN_ALPHA + g1 * acc[ai][bj][m][1];
                }
                asm volatile("" ::: "memory"); __builtin_amdgcn_sched_barrier(0);
            }
    }
};

struct EpiGU {
    static constexpr bool PERM = true;
    bf16_t* H;
    __device__ __forceinline__ void operator()(const f32x4 (&acc)[2][2][4][2], const Unit& u, int wr, int wc, int fr, int fq) const {
#pragma unroll
        for (int ai = 0; ai < 2; ++ai)
#pragma unroll
            for (int m = 0; m < 4; ++m) {
                const int row = u.pm * 256 + ai * 128 + wr * 64 + m * 16 + fr;
                const f32x4 g0 = acc[ai][0][m][0], g1 = acc[ai][0][m][1], u0 = acc[ai][1][m][0], u1 = acc[ai][1][m][1];
                f32x4 o0, o1;
#pragma unroll
                for (int k = 0; k < 4; ++k) { o0[k] = g0[k] * sigmoidf_(g0[k]) * u0[k]; o1[k] = g1[k] * sigmoidf_(g1[k]) * u1[k]; }
                *(u32x4*)(H + (size_t)row * DFF + u.pn * 128 + wc * 32 + 8 * fq) = pack8(o0, o1);
            }
    }
};

struct SchedS1 { int G, c;
    __device__ bool next(int i, Unit& u) const { const int L = i * G + c; if (L >= S5G * 5) return false; u.pm = L; u.pn = L / 5; return true; } };
struct SchedS2 { int G, c;
    __device__ bool next(int i, Unit& u) const { const int L = i * G + c; if (L >= S5G * 8) return false; const int g = L >> 3, r = L & 7; u.pm = g * 5 + (r >> 1); u.pn = g * 2 + (r & 1); return true; } };

namespace att {
using bf16x8 = __attribute__((ext_vector_type(8))) short;
using s16x4 = __attribute__((ext_vector_type(4))) short;
using f32x16 = __attribute__((ext_vector_type(16))) float;
constexpr int NW = 8, QBLK = 32, KVBLK = 64;
constexpr float SCALE = 0.10206207261596577f;
constexpr float THR = 8.f;
constexpr int SHM_V = KVBLK * 64 * 2, SHM_K = KVBLK * 256;
#define KSWZ(row, colB) ((row) * 256 + ((colB) ^ (((row) & 7) << 4)))
#define SBAR() __builtin_amdgcn_sched_barrier(0)
__device__ __forceinline__ int crow(int r, int hi) { return (r & 3) + 8 * (r >> 2) + 4 * hi; }
__device__ __forceinline__ unsigned cvtpk(float lo, float hi) { unsigned r; asm volatile("v_cvt_pk_bf16_f32 %0, %1, %2" : "=v"(r) : "v"(lo), "v"(hi)); return r; }

__device__ __forceinline__ void partialSM(f32x16& p0, f32x16& p1, float& m_reg, float& mn, float& alpha) {
  constexpr float C = SCALE * 1.4426950408889634f;
  float pmax = p0[0];
#pragma unroll
  for (int r = 1; r < 16; ++r) pmax = fmaxf(pmax, p0[r]);
#pragma unroll
  for (int r = 0; r < 16; ++r) pmax = fmaxf(pmax, p1[r]);
  { auto rr = __builtin_amdgcn_permlane32_swap(__float_as_uint(pmax), __float_as_uint(pmax), false, false);
    pmax = fmaxf(__uint_as_float(rr[0]), __uint_as_float(rr[1])); }
  if (__builtin_expect(__all(pmax - m_reg <= THR / SCALE), 1)) { mn = m_reg; alpha = 1.f; }
  else { mn = fmaxf(m_reg, pmax); alpha = __builtin_amdgcn_exp2f((m_reg - mn) * C); m_reg = mn; }
  float mnC = -mn * C;
#pragma unroll
  for (int r = 0; r < 16; ++r) p0[r] = fmaf(p0[r], C, mnC);
#pragma unroll
  for (int r = 0; r < 16; ++r) p1[r] = fmaf(p1[r], C, mnC);
#pragma unroll
  for (int r = 0; r < 16; ++r) p0[r] = __builtin_amdgcn_exp2f(p0[r]);
}
__device__ __forceinline__ void finishSM(f32x16& p0, f32x16& p1, float alpha, float& l_reg, bf16x8& pa0, bf16x8& pa1, bf16x8& pa2, bf16x8& pa3) {
#pragma unroll
  for (int r = 0; r < 16; ++r) p1[r] = __builtin_amdgcn_exp2f(p1[r]);
  float ps = 0;
#pragma unroll
  for (int r = 0; r < 16; ++r) ps += p0[r];
#pragma unroll
  for (int r = 0; r < 16; ++r) ps += p1[r];
  { auto rr = __builtin_amdgcn_permlane32_swap(__float_as_uint(ps), __float_as_uint(ps), false, false);
    ps = __uint_as_float(rr[0]) + __uint_as_float(rr[1]); }
  l_reg = l_reg * alpha + ps;
#define PK4(P, BASE, OUT) do { unsigned a0 = cvtpk(P[BASE + 0], P[BASE + 1]), a1 = cvtpk(P[BASE + 2], P[BASE + 3]);   \
    unsigned b0 = cvtpk(P[BASE + 4], P[BASE + 5]), b1 = cvtpk(P[BASE + 6], P[BASE + 7]);                              \
    auto r0 = __builtin_amdgcn_permlane32_swap(a0, b0, false, false); auto r1 = __builtin_amdgcn_permlane32_swap(a1, b1, false, false); \
    u32x4 w = {r0[0], r1[0], r0[1], r1[1]}; OUT = *reinterpret_cast<bf16x8*>(&w); } while (0)
  PK4(p0, 0, pa0); PK4(p0, 8, pa1); PK4(p1, 0, pa2); PK4(p1, 8, pa3);
#undef PK4
}
__device__ __forceinline__ void qkt(f32x16& p0, f32x16& p1, const char* Ks, const bf16x8* qr, int r32, int hi) {
  p0 = f32x16{}; p1 = f32x16{};
#pragma unroll
  for (int d0 = 0; d0 < 6; ++d0) { const int cb = (d0 * 16 + hi * 8) * 2;
    bf16x8 b0 = *reinterpret_cast<const bf16x8*>(Ks + KSWZ(r32, cb));
    bf16x8 b1 = *reinterpret_cast<const bf16x8*>(Ks + KSWZ(32 + r32, cb));
    p0 = __builtin_amdgcn_mfma_f32_32x32x16_bf16(b0, qr[d0], p0, 0, 0, 0);
    p1 = __builtin_amdgcn_mfma_f32_32x32x16_bf16(b1, qr[d0], p1, 0, 0, 0); }
}
__device__ __forceinline__ int v_st(int k, int c) { const int kk = (k & ~0xC) | ((k & 4) << 1) | ((k & 8) >> 1); return ((kk >> 3) * 2 + (c >> 5)) * 512 + ((kk & 7) * 32 + (c & 31)) * 2; }
__device__ __forceinline__ int v_rd_base(int lane) { return ((lane & 3) << 3) | (((lane >> 2) & 3) << 6) | (((lane >> 4) & 1) << 5) | (((lane >> 5) & 1) << 8); }
constexpr int v_rd_off(int d0, int ks, int half) { return d0 * 512 + ks * 2048 + half * 1024; }
template <int OFF> __device__ __forceinline__ s16x4 tr_read(int vb) {
  s16x4 r; asm volatile("ds_read_b64_tr_b16 %0, %1 offset:%2" : "=&v"(r) : "v"(vb), "i"(OFF) : "memory"); return r;
}
template <int D0> __device__ __forceinline__ void pv_one(f32x16& od, int vb, bf16x8 pa0, bf16x8 pa1, bf16x8 pa2, bf16x8 pa3) {
  const s16x4 l0 = tr_read<v_rd_off(D0, 0, 0)>(vb), h0 = tr_read<v_rd_off(D0, 0, 1)>(vb), l1 = tr_read<v_rd_off(D0, 1, 0)>(vb), h1 = tr_read<v_rd_off(D0, 1, 1)>(vb);
  const s16x4 l2 = tr_read<v_rd_off(D0, 2, 0)>(vb), h2 = tr_read<v_rd_off(D0, 2, 1)>(vb), l3 = tr_read<v_rd_off(D0, 3, 0)>(vb), h3 = tr_read<v_rd_off(D0, 3, 1)>(vb);
  asm volatile("s_waitcnt lgkmcnt(0)" ::: "memory"); SBAR();
#define PK(L, H) (bf16x8){L[0], L[1], L[2], L[3], H[0], H[1], H[2], H[3]}
  od = __builtin_amdgcn_mfma_f32_32x32x16_bf16(pa0, PK(l0, h0), od, 0, 0, 0);
  od = __builtin_amdgcn_mfma_f32_32x32x16_bf16(pa1, PK(l1, h1), od, 0, 0, 0);
  od = __builtin_amdgcn_mfma_f32_32x32x16_bf16(pa2, PK(l2, h2), od, 0, 0, 0);
  od = __builtin_amdgcn_mfma_f32_32x32x16_bf16(pa3, PK(l3, h3), od, 0, 0, 0);
#undef PK
}
__device__ __forceinline__ void pv_d0(f32x16* o, int vb, bf16x8 pa0, bf16x8 pa1, bf16x8 pa2, bf16x8 pa3) {
  pv_one<0>(o[0], vb, pa0, pa1, pa2, pa3); pv_one<1>(o[1], vb, pa0, pa1, pa2, pa3);
}

__device__ __forceinline__ void attn_unit(const bf16_t* __restrict__ Qb, const bf16_t* __restrict__ Kh, const bf16_t* __restrict__ Vh, bf16_t* __restrict__ Ob, char* lds) {
  int tid_ = threadIdx.x; asm volatile("" : "+v"(tid_));
  const int tid = tid_, wid = tid >> 6, lane = tid & 63, r32 = lane & 31, hi = lane >> 5;
  char* V_lds = lds; char* K_lds = lds + 2 * SHM_V;
  float* ws = (float*)(lds + 2 * SHM_V + 2 * SHM_K) + wid * 64; float* li_l = ws; float* al_l = ws + 32;
  float m_reg = -1e30f, l_reg = 0; f32x16 o[2] = {}; bf16x8 qr[6];
  const bf16_t* Qw = Qb + (size_t)(wid * QBLK + r32) * 96 + hi * 8;
#pragma unroll
  for (int d0 = 0; d0 < 6; ++d0) qr[d0] = *reinterpret_cast<const bf16x8*>(Qw + d0 * 16);
  const int kc0 = tid, kc1 = 512 + (tid & 255);
  const int kst0 = KSWZ(kc0 / 12, (kc0 % 12) * 16), kst1 = KSWZ(kc1 / 12, (kc1 % 12) * 16);
  const int vst0 = v_st(tid >> 3, (tid & 7) * 8);
  const int vb0 = (int)(uintptr_t)V_lds + v_rd_base(lane);
  const char* Kg = (const char*)Kh; const char* Vg = (const char*)Vh;
  struct { bf16x8 k0, k1, v0; } sr_[2];
#define SLOAD(i, t) do { const char* kb_ = Kg + (size_t)(t) * 12288; const char* vb_ = Vg + (size_t)(t) * 8192; \
    sr_[i].k0 = *reinterpret_cast<const bf16x8*>(kb_ + kc0 * 16); sr_[i].k1 = *reinterpret_cast<const bf16x8*>(kb_ + kc1 * 16); sr_[i].v0 = *reinterpret_cast<const bf16x8*>(vb_ + tid * 16); } while (0)
#define SWRITE(b, i) do { *(bf16x8*)(V_lds + (b) * SHM_V + vst0) = sr_[i].v0; *(bf16x8*)(K_lds + (b) * SHM_K + kst0) = sr_[i].k0; \
    if (wid < 4) *(bf16x8*)(K_lds + (b) * SHM_K + kst1) = sr_[i].k1; } while (0)
#define SWAIT() asm volatile("s_waitcnt vmcnt(3)" ::: "memory")
#define RESC(a) do { if (__any((a) < 1.f)) { if (hi == 0) al_l[r32] = (a); asm volatile("s_waitcnt lgkmcnt(0)" ::: "memory"); \
    _Pragma("unroll") for (int d = 0; d < 2; ++d) _Pragma("unroll") for (int r = 0; r < 16; ++r) o[d][r] *= al_l[crow(r, hi)]; } } while (0)
  f32x16 pA0, pA1, pB0, pB1; float mnA, mnB, alA, alB; bf16x8 pa0, pa1, pa2, pa3; constexpr int NT = LK / KVBLK;
  SLOAD(0, 0); asm volatile("s_waitcnt vmcnt(0)" ::: "memory"); SWRITE(0, 0); __syncthreads();
  qkt(pA0, pA1, K_lds, qr, r32, hi); partialSM(pA0, pA1, m_reg, mnA, alA);
  SLOAD(1, 1); SLOAD(0, 2);
  SWAIT(); SWRITE(1, 1); __syncthreads();
  for (int j = 1; j + 1 < NT; j += 2) {
    SBAR(); qkt(pB0, pB1, K_lds + SHM_K, qr, r32, hi);
    finishSM(pA0, pA1, alA, l_reg, pa0, pa1, pa2, pa3); SBAR();
    SLOAD(1, j + 2); SBAR();
    pv_d0(o, vb0, pa0, pa1, pa2, pa3); partialSM(pB0, pB1, m_reg, mnB, alB);
    __syncthreads(); SWAIT(); SWRITE(0, 0);
    RESC(alB); __syncthreads();
    SBAR(); qkt(pA0, pA1, K_lds, qr, r32, hi);
    finishSM(pB0, pB1, alB, l_reg, pa0, pa1, pa2, pa3); SBAR();
    if (j + 3 < NT) SLOAD(0, j + 3); SBAR();
    pv_d0(o, vb0 + SHM_V, pa0, pa1, pa2, pa3); partialSM(pA0, pA1, m_reg, mnA, alA);
    __syncthreads(); SWAIT(); SWRITE(1, 1);
    RESC(alA); __syncthreads();
  }
  SBAR(); qkt(pB0, pB1, K_lds + SHM_K, qr, r32, hi);
  finishSM(pA0, pA1, alA, l_reg, pa0, pa1, pa2, pa3); SBAR();
  pv_d0(o, vb0, pa0, pa1, pa2, pa3); partialSM(pB0, pB1, m_reg, mnB, alB);
  __syncthreads(); RESC(alB);
  finishSM(pB0, pB1, alB, l_reg, pa0, pa1, pa2, pa3); SBAR();
  pv_d0(o, vb0 + SHM_V, pa0, pa1, pa2, pa3);
  if (hi == 0) li_l[r32] = l_reg; asm volatile("s_waitcnt lgkmcnt(0)" ::: "memory");
  float rli[16];
#pragma unroll
  for (int r = 0; r < 16; ++r) rli[r] = __builtin_amdgcn_rcpf(li_l[crow(r, hi)]);
  bf16_t* Ow = Ob + (size_t)(wid * QBLK) * DM;
#pragma unroll
  for (int r = 0; r < 16; ++r) { const int orow = crow(r, hi);
#pragma unroll
    for (int d0 = 0; d0 < 2; ++d0) { const unsigned w = cvtpk(o[d0][r] * rli[r], 0.f); Ow[(size_t)orow * DM + d0 * 32 + r32] = (bf16_t)(w & 0xffffu); } }
  __syncthreads();
#undef SLOAD
#undef SWRITE
#undef SWAIT
#undef RESC
}
#undef SBAR
}

#define LAS __attribute__((address_space(3)))
__device__ __forceinline__ float wave_sum(float v) {
#pragma unroll
    for (int o = 1; o < 64; o <<= 1) v += __shfl_xor(v, o);
    return v;
}
__device__ __forceinline__ unsigned pk2(float lo, float hi) { return pg8::cvt_pk_bf16(lo, hi); }

__device__ __forceinline__ void transpose_item(const float* W, int N, bf16_t* WT, int ldt, int k0, int n0, int drow0, const float* kscale, float* scr, int lane) {
#pragma unroll 8
    for (int i = 0; i < 32; ++i) { const int kk = 2 * i + (lane >> 5); float v = W[(size_t)(k0 + kk) * N + n0 + (lane & 31)]; if (kscale) v *= kscale[k0 + kk]; scr[kk * 33 + (lane & 31)] = v; }
    asm volatile("s_waitcnt lgkmcnt(0)" ::: "memory");
    const int c = lane & 7;
#pragma unroll
    for (int j = 0; j < 4; ++j) { const int n = (lane >> 3) + 8 * j; const float* s = scr + (8 * c) * 33 + n;
        u32x4 o; o.x = pk2(s[0 * 33], s[1 * 33]); o.y = pk2(s[2 * 33], s[3 * 33]); o.z = pk2(s[4 * 33], s[5 * 33]); o.w = pk2(s[6 * 33], s[7 * 33]);
        *(u32x4*)(WT + (size_t)(drow0 + n) * ldt + k0 + 8 * c) = o; }
    asm volatile("s_waitcnt lgkmcnt(0)" ::: "memory");
}

__device__ __forceinline__ void row_stats(const f32x4 (&v)[4], float& mean, float& rstd) {
    float s = 0.f;
#pragma unroll
    for (int j = 0; j < 4; ++j) s += (v[j][0] + v[j][1]) + (v[j][2] + v[j][3]);
    mean = wave_sum(s) * (1.f / DM); float s2 = 0.f;
#pragma unroll
    for (int j = 0; j < 4; ++j) { const f32x4 d = v[j] - mean; s2 += (d[0] * d[0] + d[1] * d[1]) + (d[2] * d[2] + d[3] * d[3]); }
    rstd = 1.f / sqrtf(wave_sum(s2) * (1.f / DM) + EPS);
}

#ifndef PHASES
#define PHASES 0xFFF
#endif
constexpr int NWAVES = 8, NTHREADS = 512, LDS_BYTES = 147456;

__global__ void __launch_bounds__(NTHREADS, 2) hymba_fwd(Params P) {
    extern __shared__ __attribute__((aligned(16))) unsigned char lds[];
    cg::grid_group grid = cg::this_grid();
    const int G = gridDim.x, bx = blockIdx.x;
    const int vcu = (G % 8 == 0) ? (bx % 8) * (G / 8) + bx / 8 : bx;
    const int NGW = G * NWAVES; const long NGT = (long)G * NTHREADS;
#define PHASE_IDS int tid_ = threadIdx.x; asm volatile("" : "+v"(tid_)); const int tid = tid_, lane = tid & 63, wave = __builtin_amdgcn_readfirstlane(tid >> 6); \
    const int gw = vcu * NWAVES + wave; const long gt = (long)bx * NTHREADS + tid; (void)lane; (void)gw; (void)gt;
    unsigned char* ws = P.ws;
    const float* x = P.in[0]; const float* cnd = P.in[1]; const float* ctx = P.in[2]; const float* cctx = P.in[3];
    const float* w_ada = P.in[4]; const float* b_ada = P.in[5];
    float* mods = (float*)(ws + WS_MODS); f32x2v* rope = (f32x2v*)(ws + WS_ROPE); f32x2v* AP = (f32x2v*)(ws + WS_AP); f32x2v* BBAR = (f32x2v*)(ws + WS_BBAR);
    float* KT = (float*)(ws + WS_KT); float* SS = (float*)(ws + WS_SS);
    bf16_t* WIN = (bf16_t*)(ws + WS_WIN); bf16_t* WUQ = (bf16_t*)(ws + WS_WUQ); bf16_t* WKV = (bf16_t*)(ws + WS_WKV); bf16_t* WGLU = (bf16_t*)(ws + WS_WGLU);
    bf16_t* WOUT = (bf16_t*)(ws + WS_WOUT); bf16_t* WGU = (bf16_t*)(ws + WS_WGU); bf16_t* WDN = (bf16_t*)(ws + WS_WDN);
    bf16_t* FM = (bf16_t*)(ws + WS_FM); bf16_t* ME = (bf16_t*)(ws + WS_ME); bf16_t* XN = (bf16_t*)(ws + WS_XN);
    bf16_t* HB = (bf16_t*)(ws + WS_H); bf16_t* PQ = (bf16_t*)(ws + WS_PQ); bf16_t* PKV = (bf16_t*)(ws + WS_PKV); bf16_t* A2 = (bf16_t*)(ws + WS_A2);
    float* LB = (float*)(ws + WS_LB); bf16_t* Qb = (bf16_t*)(ws + WS_Q); bf16_t* Kb = (bf16_t*)(ws + WS_K); bf16_t* Vb = (bf16_t*)(ws + WS_V);
    bf16_t* Zb = (bf16_t*)(ws + WS_Z); bf16_t* CAT = (bf16_t*)(ws + WS_CAT);
    PG8_LAS unsigned char* ldsl = (PG8_LAS unsigned char*)lds;

    if (PHASES & (1 << 0)) {
    PHASE_IDS
    if (bx < 192) {
        float* sc = (float*)lds;
        float* red = (float*)lds + 9 * 1024;
        for (int i = tid; i < 9 * 1024; i += NTHREADS) { const int r = i >> 10, k = i & 1023; const float v = r < 8 ? cnd[r * 1024 + k] : cctx[k]; sc[i] = v / (1.f + __expf(-v)); }
        __syncthreads();
        const int j = tid & 31, kk = tid >> 5, col = bx * 32 + j;
        float a[9];
#pragma unroll
        for (int r = 0; r < 9; ++r) a[r] = 0.f;
        for (int k = kk; k < 1024; k += 16) { const float w = w_ada[(size_t)k * 6144 + col];
#pragma unroll
            for (int r = 0; r < 9; ++r) a[r] += sc[r * 1024 + k] * w; }
#pragma unroll
        for (int r = 0; r < 9; ++r) red[(kk * 9 + r) * 32 + j] = a[r];
        __syncthreads();
        if (tid < 288) { const int r = tid >> 5, jj = tid & 31; float s = 0.f;
#pragma unroll
            for (int q = 0; q < 16; ++q) s += red[(q * 9 + r) * 32 + jj];
            mods[r * 6144 + bx * 32 + jj] = s + b_ada[bx * 32 + jj]; }
        __syncthreads();
    }
    {
        float* scr = (float*)(lds + wave * 16384);
        constexpr int NITEMS = 592 + 144 + 64 + 64 + 128 + 512 + 2816 + 1408;
        for (int it = gw; it < NITEMS; it += NGW) {
            int r = it;
            if (r < 592) { const int kb = r / 37, nb = r % 37; transpose_item(P.in[6], DIN, WIN, 1024, 64 * kb, 32 * nb, 32 * nb, nullptr, scr, lane); continue; } r -= 592;
            if (r < 144) { const int kb = r / 24, nb = r % 24; transpose_item(P.in[9], 768, WUQ, QLR, 64 * kb, 32 * nb, 32 * nb, P.in[7], scr, lane); continue; } r -= 144;
            if (r < 64) { const int kb = r / 16, nb = r % 16; transpose_item(P.in[10], 512, WKV, KVLR, 64 * kb, 32 * nb, 32 * nb, P.in[8], scr, lane); continue; } r -= 64;
            if (r < 64) { const int kb = r / 16, nb = r % 16; transpose_item(P.in[11], 512, WKV, KVLR, 64 * kb, 32 * nb, 512 + 32 * nb, P.in[8], scr, lane); continue; } r -= 64;
            if (r < 128) { const int kb = r / 16, nb = r % 16; transpose_item(P.in[20], 512, WGLU, 512, 64 * kb, 32 * nb, 32 * nb, nullptr, scr, lane); continue; } r -= 128;
            if (r < 512) { const int kb = r / 32, nb = r % 32; transpose_item(P.in[22], 1024, WOUT, 1024, 64 * kb, 32 * nb, 32 * nb, nullptr, scr, lane); continue; } r -= 512;
            if (r < 2816) { const int kb = r / 176, nb = r % 176, n0 = 32 * nb; const int n1 = n0 < DFF ? n0 : n0 - DFF; const int dr = (n1 >> 7) * 256 + (n1 & 127) + (n0 < DFF ? 0 : 128);
                transpose_item(P.in[25], 2 * DFF, WGU, 1024, 64 * kb, n0, dr, nullptr, scr, lane); continue; } r -= 2816;
            { const int kb = r / 32, nb = r % 32; transpose_item(P.in[26], 1024, WDN, DFF, 64 * kb, 32 * nb, 32 * nb, nullptr, scr, lane); }
        }
    }
    for (long i = gt; i < 96 * 1024 / 8; i += NGT) *(u32x4*)(WIN + (size_t)DIN * 1024 + i * 8) = (u32x4){0u, 0u, 0u, 0u};
    for (long i = gt; i < SEQ * 16; i += NGT) {
        const int l = (int)(i >> 4), pi = (int)(i & 15), f = pi & 7; const double pos = pi < 8 ? (double)(l >> 6) : (double)(l & 63);
        const double ang = pos * pow(10000.0, -(double)f / 8.0);
        rope[i] = (f32x2v){(float)cos(ang), (float)sin(ang)};
    }
    for (long i = gt; i < S5G * 2 * S5P * 33; i += NGT) {
        const int d = (int)(i % 33); const int r = (int)(i / 33), p = r & 63, dir = (r >> 6) & 1, g = r >> 7;
        const int li = (dir * S5G + g) * S5P + p;
        const double dt = exp((double)P.in[14][dir * S5G + g]), lr = (double)P.in[12][li], lim = (double)P.in[13][li];
        const double mag = exp(lr * dt * d), ang = lim * dt * d;
        AP[i] = (f32x2v){(float)(mag * cos(ang)), (float)(mag * sin(ang))};
    }
    for (long i = gt; i < S5G * 2 * S5P; i += NGT) {
        const int p = (int)(i & 63), dir = (int)((i >> 6) & 1), g = (int)(i >> 7);
        const int li = (dir * S5G + g) * S5P + p;
        const double dt = exp((double)P.in[14][dir * S5G + g]), lr = (double)P.in[12][li], lim = (double)P.in[13][li];
        const double mag = exp(lr * dt), are = mag * cos(lim * dt), aim = mag * sin(lim * dt), den = lr * lr + lim * lim;
        const double fre = ((are - 1.0) * lr + aim * lim) / den, fim = (aim * lr - (are - 1.0) * lim) / den;
#pragma unroll 4
        for (int c = 0; c < 16; ++c) { const double br = (double)P.in[15][(size_t)li * 16 + c], bi = (double)P.in[16][(size_t)li * 16 + c];
            BBAR[i * 16 + c] = (f32x2v){(float)(fre * br - fim * bi), (float)(fre * bi + fim * br)}; }
    }
    }
    grid.sync();

    if (PHASES & (1 << 1)) {
    PHASE_IDS
    for (int row = gw; row < MALL; row += NGW) {
        const bool latr = row < MLAT; const float* src = latr ? x + (size_t)row * DM : ctx + (size_t)(row - MLAT) * DM; const int r = latr ? (row >> 12) : 8;
        const f32x4* xr = (const f32x4*)src + lane; f32x4 v[4];
#pragma unroll
        for (int j = 0; j < 4; ++j) v[j] = xr[64 * j];
        float mean, rstd; row_stats(v, mean, rstd);
        const f32x4* sh = (const f32x4*)(mods + r * 6144) + lane; const f32x4* scl = (const f32x4*)(mods + r * 6144 + 1024) + lane;
        unsigned long long* o8 = (unsigned long long*)(XN + (size_t)row * DM) + lane;
#pragma unroll
        for (int j = 0; j < 4; ++j) { const f32x4 s_ = sh[64 * j], c_ = scl[64 * j]; const f32x4 y = (v[j] - mean) * rstd * (c_ + 1.0f) + s_;
            o8[64 * j] = (unsigned long long)pk2(y[0], y[1]) | ((unsigned long long)pk2(y[2], y[3]) << 32); }
    }
    for (long i = gt; i < (long)S5G * 256 * 64; i += NGT) {
        const int c8 = (int)(i & 1), j = (int)((i >> 1) & 31), r = (int)((i >> 6) & 255), g = (int)(i >> 14);
        const int ri = r & 1, p = (r >> 1) & 63, dir = r >> 7;
        const int ab = ((g * 2 + dir) * S5P + p);
        const f32x2v a = AP[ab * 33 + (dir == 0 ? 31 - j : j)];
        float o[8];
#pragma unroll
        for (int c = 0; c < 8; ++c) { const f32x2v bb = BBAR[(size_t)ab * 16 + c8 * 8 + c]; o[c] = ri == 0 ? a.x * bb.x - a.y * bb.y : a.x * bb.y + a.y * bb.x; }
        u32x4 w; w.x = pk2(o[0], o[1]); w.y = pk2(o[2], o[3]); w.z = pk2(o[4], o[5]); w.w = pk2(o[6], o[7]);
        *(u32x4*)(FM + ((size_t)g * 256 + r) * 512 + j * 16 + c8 * 8) = w;
    }
    for (long i = gt; i < (long)S5G * 512 * 32; i += NGT) {
        const int q = (int)(i & 31), rr = (int)((i >> 5) & 511), g = (int)(i >> 14);
        const int dir = q >> 4, p0 = (q & 15) * 4, ti = rr >> 4, co = rr & 15;
        float o[8];
#pragma unroll
        for (int k = 0; k < 4; ++k) { const int p = p0 + k; const size_t ci = ((size_t)(dir * S5G + g) * 16 + co) * S5P + p;
            const float cr = P.in[17][ci], cim = P.in[18][ci];
            const f32x2v a = AP[((g * 2 + dir) * S5P + p) * 33 + (dir == 0 ? ti + 1 : 32 - ti)];
            o[2 * k] = cr * a.x - cim * a.y; o[2 * k + 1] = -(cr * a.y + cim * a.x); }
        u32x4 w; w.x = pk2(o[0], o[1]); w.y = pk2(o[2], o[3]); w.z = pk2(o[4], o[5]); w.w = pk2(o[6], o[7]);
        *(u32x4*)(ME + ((size_t)g * 512 + rr) * 768 + 512 + dir * 128 + p0 * 2) = w;
    }
    for (long i = gt; i < (long)S5G * 2 * 32 * 256; i += NGT) {
        const int ci = (int)(i & 15), co = (int)((i >> 4) & 15), d = (int)((i >> 8) & 31), dir = (int)((i >> 13) & 1), g = (int)(i >> 14);
        float s = 0.f;
        for (int p = 0; p < S5P; ++p) { const size_t cidx = ((size_t)(dir * S5G + g) * 16 + co) * S5P + p; const float cr = P.in[17][cidx], cim = P.in[18][cidx];
            const int ab = (g * 2 + dir) * S5P + p; const f32x2v a = AP[ab * 33 + d], bb = BBAR[(size_t)ab * 16 + ci];
            const float gr = cr * a.x - cim * a.y, gi = cr * a.y + cim * a.x; s += gr * bb.x - gi * bb.y; }
        KT[i] = s;
    }
    }
    grid.sync();

    if (PHASES & (1 << 2)) {
    PHASE_IDS
    for (long i = gt; i < (long)S5G * 512 * 64; i += NGT) {
        const int c8 = (int)(i & 1), j = (int)((i >> 1) & 31), rr = (int)((i >> 6) & 511), g = (int)(i >> 15);
        const int ti = rr >> 4, co = rr & 15;
        float o[8];
#pragma unroll
        for (int k = 0; k < 8; ++k) o[k] = 0.f;
        if (j <= ti) { const float* kp = KT + ((((size_t)g * 2 + 0) * 32 + (ti - j)) * 16 + co) * 16 + c8 * 8;
#pragma unroll
            for (int k = 0; k < 8; ++k) o[k] += kp[k]; }
        if (j >= ti) { const float* kp = KT + ((((size_t)g * 2 + 1) * 32 + (j - ti)) * 16 + co) * 16 + c8 * 8;
#pragma unroll
            for (int k = 0; k < 8; ++k) o[k] += kp[k]; }
        if (j == ti && (co >> 3) == c8) { const float dv = P.in[19][g * 16 + co];
#pragma unroll
            for (int k = 0; k < 8; ++k) if (k == (co & 7)) o[k] += dv; }
        u32x4 w; w.x = pk2(o[0], o[1]); w.y = pk2(o[2], o[3]); w.z = pk2(o[4], o[5]); w.w = pk2(o[6], o[7]);
        *(u32x4*)(ME + ((size_t)g * 512 + rr) * 768 + j * 16 + c8 * 8) = w;
    }
    __syncthreads();
    {
        pg8::Gemm g{XN, WIN, 1024, 1024, 1024}; pg8::StaticOrder S; S.init(MALL, 1280, G, bx);
        EpiIn E{PQ, PKV, SS, Kb, A2, rope};
        pg8::gemm_phase<EpiIn, pg8::StaticOrder, true>(ldsl, g, S, E);
    }
    }
    grid.sync();

    if (PHASES & (1 << 3)) {
    PHASE_IDS
#ifndef DSEL
#define DSEL 7
#endif
    if (DSEL & 1) {
        pg8::Gemm g{A2, FM, 512, 768, 512}; SchedS1 S{G, (bx + G - 96) % G};
        EpiS1 E{LB};
        pg8::gemm_phase<EpiS1, SchedS1, true>(ldsl, g, S, E);
    }
    if (DSEL & 2) {
        pg8::Gemm g{PQ, WUQ, QLR, QLR, QLR}; pg8::StaticOrder S; S.init(MLAT, 768, G, bx);
        EpiQ E{Qb, SS, rope};
        pg8::gemm_phase<EpiQ, pg8::StaticOrder, true>(ldsl, g, S, E);
    }
    if (DSEL & 4) {
        pg8::Gemm g{PKV, WKV, KVLR, KVLR, KVLR}; pg8::StaticOrder S; S.init(MALL, 1024, G, bx);
        EpiKV E{Kb, Vb, SS};
        pg8::gemm_phase<EpiKV, pg8::StaticOrder, true>(ldsl, g, S, E);
    }
    }
    grid.sync();

    if (PHASES & (1 << 4)) {
    PHASE_IDS
    for (long i = gt; i < (long)S5G * NB * 2 * S5P; i += NGT) {
        const int p = (int)(i & 63), dir = (int)((i >> 6) & 1), b = (int)((i >> 7) & 7), g = (int)(i >> 10);
        const f32x2v at = AP[((g * 2 + dir) * S5P + p) * 33 + 32];
        float hr = 0.f, hi_ = 0.f;
        const size_t colL = dir * 128 + p * 2;
        for (int s0 = 0; s0 < 136; s0 += 8) {
            f32x2v lv[8]; int nn[8];
#pragma unroll
            for (int k = 0; k < 8; ++k) { const int s = s0 + k;
                int n; if (dir == 0) n = s < 8 ? 1024 + b * 8 + s : b * 128 + (s - 8); else n = s < 8 ? 1024 + b * 8 + (7 - s) : b * 128 + (135 - s);
                nn[k] = n; lv[k] = *(const f32x2v*)(LB + ((size_t)g * NCH + n) * 256 + colL); }
#pragma unroll
            for (int k = 0; k < 8; ++k) {
                *(unsigned*)(A2 + ((size_t)g * NCH + nn[k]) * 768 + 512 + colL) = pk2(hr, hi_);
                const float nr = at.x * hr - at.y * hi_ + lv[k].x, ni = at.x * hi_ + at.y * hr + lv[k].y; hr = nr; hi_ = ni;
            }
        }
    }
    }
    grid.sync();

    if (PHASES & (1 << 5)) {
    PHASE_IDS
    {
        pg8::Gemm g{A2, ME, 768, 768, 768}; SchedS2 S{G, bx};
        EpiS2 E{Zb};
        pg8::gemm_phase<EpiS2, SchedS2, true>(ldsl, g, S, E);
    }
    __syncthreads();
    for (int i = 0; i < 4; ++i) {
        const int ui = i * G + vcu; if (ui >= NB * NH * 16) break;
        const int bh = ui >> 4, qb = ui & 15, b = bh >> 3, h = bh & 7;
        att::attn_unit(Qb + ((size_t)bh * SEQ + qb * 256) * 96, Kb + (size_t)bh * LK * 96, Vb + (size_t)bh * LK * 64,
                       CAT + ((size_t)b * SEQ + qb * 256) * DM + h * 64, (char*)lds);
    }
    }
    grid.sync();

    if (PHASES & (1 << 6)) {
    PHASE_IDS
    {
        pg8::Gemm g{Zb, WGLU, 512, 512, 512}; pg8::StaticOrder S; S.init(MLAT, 512, G, bx);
        EpiGlu E{Zb, CAT, P.in[21]};
        pg8::gemm_phase<EpiGlu, pg8::StaticOrder, true>(ldsl, g, S, E);
    }
    }
    grid.sync();

    if (PHASES & (1 << 7)) {
    PHASE_IDS
    {
        pg8::Gemm g{CAT, WOUT, 1024, 1024, 1024}; pg8::StaticOrder S; S.init(MLAT, 1024, G, bx);
        EpiRes E{x, P.out, mods + 2048};
        pg8::gemm_phase<EpiRes, pg8::StaticOrder, true>(ldsl, g, S, E);
    }
    }
    grid.sync();

    if (PHASES & (1 << 8)) {
    PHASE_IDS
    for (int row = gw; row < MLAT; row += NGW) {
        const int r = row >> 12;
        f32x4* xr = (f32x4*)(P.out + (size_t)row * DM) + lane; f32x4 v[4];
#pragma unroll
        for (int j = 0; j < 4; ++j) v[j] = xr[64 * j];
        float mean, rstd; row_stats(v, mean, rstd);
        const f32x4* gp = (const f32x4*)P.in[23] + lane; const f32x4* bp = (const f32x4*)P.in[24] + lane;
#pragma unroll
        for (int j = 0; j < 4; ++j) { v[j] = (v[j] - mean) * rstd * gp[64 * j] + bp[64 * j]; xr[64 * j] = v[j]; }
        row_stats(v, mean, rstd);
        const f32x4* sh = (const f32x4*)(mods + r * 6144 + 3072) + lane; const f32x4* scl = (const f32x4*)(mods + r * 6144 + 4096) + lane;
        unsigned long long* o8 = (unsigned long long*)(XN + (size_t)row * DM) + lane;
#pragma unroll
        for (int j = 0; j < 4; ++j) { const f32x4 s_ = sh[64 * j], c_ = scl[64 * j]; const f32x4 y = (v[j] - mean) * rstd * (c_ + 1.0f) + s_;
            o8[64 * j] = (unsigned long long)pk2(y[0], y[1]) | ((unsigned long long)pk2(y[2], y[3]) << 32); }
    }
    }
    grid.sync();

    if (PHASES & (1 << 9)) {
    PHASE_IDS
    {
        pg8::Gemm g{XN, WGU, 1024, 1024, 1024}; pg8::StaticOrder S; S.init(MLAT, 2 * DFF, G, bx);
        EpiGU E{HB};
        pg8::gemm_phase<EpiGU, pg8::StaticOrder, true>(ldsl, g, S, E);
    }
    }
    grid.sync();

    if (PHASES & (1 << 10)) {
    PHASE_IDS
    {
        pg8::Gemm g{HB, WDN, DFF, DFF, DFF}; pg8::StaticOrder S; S.init(MLAT, 1024, G, bx);
        EpiRes E{P.out, P.out, mods + 5120};
        pg8::gemm_phase<EpiRes, pg8::StaticOrder, true>(ldsl, g, S, E);
    }
    }
    grid.sync();

    if (PHASES & (1 << 11)) {
    PHASE_IDS
    for (int row = gw; row < MLAT; row += NGW) {
        f32x4* xr = (f32x4*)(P.out + (size_t)row * DM) + lane; f32x4 v[4];
#pragma unroll
        for (int j = 0; j < 4; ++j) v[j] = xr[64 * j];
        float mean, rstd; row_stats(v, mean, rstd);
        const f32x4* gp = (const f32x4*)P.in[27] + lane; const f32x4* bp = (const f32x4*)P.in[28] + lane;
#pragma unroll
        for (int j = 0; j < 4; ++j) xr[64 * j] = (v[j] - mean) * rstd * gp[64 * j] + bp[64 * j];
    }
    }
}

extern "C" void kernel_launch(void* const* d_in, const int* in_sizes, int n_in, void* d_out, int out_size, void* d_ws, size_t ws_size, hipStream_t stream) {
    static int grid = 0;
    if (grid == 0) {
        if (n_in != 29 || in_sizes[0] != MLAT * DM || out_size != MLAT * DM || ws_size < WS_END) {
            fprintf(stderr, "kernel_launch: unexpected shapes: n_in %d in0 %d out %d ws %zu (need >= %zu)\n", n_in, n_in > 0 ? in_sizes[0] : -1, out_size, ws_size, (size_t)WS_END); grid = -1; return; }
        int dev = 0, cus = 0, per_cu = 0;
        if (hipGetDevice(&dev) != hipSuccess || hipDeviceGetAttribute(&cus, hipDeviceAttributeMultiprocessorCount, dev) != hipSuccess) { grid = -1; return; }
        if (hipFuncSetAttribute((const void*)hymba_fwd, hipFuncAttributeMaxDynamicSharedMemorySize, LDS_BYTES) != hipSuccess) { fprintf(stderr, "kernel_launch: hipFuncSetAttribute failed\n"); grid = -1; return; }
        if (hipOccupancyMaxActiveBlocksPerMultiprocessor(&per_cu, (const void*)hymba_fwd, NTHREADS, LDS_BYTES) != hipSuccess || per_cu < 1) { fprintf(stderr, "kernel_launch: occupancy query says %d\n", per_cu); per_cu = 1; }
        (void)hipGetLastError();
        grid = cus * per_cu;
    }
    if (grid < 0) return;
    Params p{};
    for (int i = 0; i < 29; ++i) p.in[i] = (const float*)d_in[i];
    p.out = (float*)d_out; p.ws = (unsigned char*)d_ws;
    void* args[] = {&p};
    hipError_t e = hipLaunchCooperativeKernel((const void*)hymba_fwd, dim3(grid), dim3(NTHREADS), args, LDS_BYTES, stream);
    if (e != hipSuccess) fprintf(stderr, "kernel_launch: cooperative launch failed: %s (grid %d)\n", hipGetErrorString(e), grid);
}
```

```cpp
#include <hip/hip_runtime.h>
#include <hip/hip_cooperative_groups.h>
#include <hip/hip_bf16.h>
#include <cstdio>
#include <cstdint>
#include <cmath>
namespace cg = cooperative_groups;

namespace pg8 {
#define PG8_LAS __attribute__((address_space(3)))
typedef unsigned short bf16_t;
typedef short bf16x8 __attribute__((ext_vector_type(8)));
typedef float f32x4 __attribute__((ext_vector_type(4)));
typedef float f32x2 __attribute__((ext_vector_type(2)));
typedef unsigned u32x4 __attribute__((ext_vector_type(4)));
constexpr int BM = 256, BK = 64, HALF = 128, HTB = HALF * BK * 2, STAGE_BYTES = 8 * HTB, NXCD = 8, WGM = 8;

__host__ __device__ __forceinline__ int lds_byte(int r, int c) { const int st = (r >> 4) * 2 + (c >> 5), rr = r & 15, cc = c & 31, ob = rr * 64 + cc * 2; return st * 1024 + (ob ^ (((ob >> 9) & 1) << 5)); }
__host__ __device__ __forceinline__ void stage_rc(int b, int& R, int& C) { const int st = b / 1024, sb = b % 1024, swz = sb ^ (((sb >> 9) & 1) << 5); R = (st >> 1) * 16 + swz / 64; C = (st & 1) * 32 + (swz % 64) / 2; }
__host__ __device__ __forceinline__ int perm32(int rho) { const int n = rho >> 4, i = rho & 15; return 8 * (i >> 2) + 4 * n + (i & 3); }

struct Unit { int pm, pn; };
struct Gemm { const bf16_t* A; const bf16_t* Bt; int K, lda, ldb; };

struct StaticOrder {
    int nM, nN, nwg, G, c;
    __device__ void init(int M, int N, int G_, int c_) { nM = M / BM; nN = N / BM; nwg = nM * nN; G = G_; c = c_; }
    __device__ bool next(int i, Unit& u) const {
        const long L = (long)i * G + c; if (L >= nwg) return false;
        int wgid = (int)L; { const int q = nwg / NXCD, r = nwg % NXCD, xcd = wgid % NXCD, off = wgid / NXCD; wgid = (xcd < r ? xcd * (q + 1) : r * (q + 1) + (xcd - r) * q) + off; }
        const int nig = WGM * nN, gid = wgid / nig, fm = gid * WGM, gsz = (nM - fm) < WGM ? (nM - fm) : WGM;
        u.pm = fm + ((wgid % nig) % gsz); u.pn = (wgid % nig) / gsz; return true;
    }
};

__device__ __forceinline__ unsigned cvt_pk_bf16(float lo, float hi) { unsigned r; asm volatile("v_cvt_pk_bf16_f32 %0, %1, %2" : "=v"(r) : "v"(lo), "v"(hi)); return r; }
__device__ __forceinline__ u32x4 pack8(f32x4 v0, f32x4 v1) { u32x4 w; w.x = cvt_pk_bf16(v0[0], v0[1]); w.y = cvt_pk_bf16(v0[2], v0[3]); w.z = cvt_pk_bf16(v1[0], v1[1]); w.w = cvt_pk_bf16(v1[2], v1[3]); return w; }

template <class Epi, class Sched, bool ALIGN_EPI>
__device__ __forceinline__ void gemm_phase(PG8_LAS unsigned char* lds, const Gemm g, const Sched& S, const Epi& E) {
    int tid_ = threadIdx.x; asm volatile("" : "+v"(tid_));
    const int tid = tid_, wid = __builtin_amdgcn_readfirstlane(tid >> 6), lane = tid & 63, wr = wid >> 2, wc = wid & 3, fr = lane & 15, fq = lane >> 4;
    int K_ = g.K; asm volatile("" : "+s"(K_));
    const int K = K_, nt = K / BK;
    unsigned voffA[2], voffB[2];
#pragma unroll
    for (int i = 0; i < 2; ++i) { int R, C; stage_rc(tid * 16 + i * 8192, R, C); const int Rb = Epi::PERM ? ((R & ~31) + perm32(R & 31)) : R;
        voffA[i] = (unsigned)(R * g.lda + C) * 2u; voffB[i] = (unsigned)(Rb * g.ldb + C) * 2u; }
    const size_t kstep = (size_t)(BK * 2);
    const size_t hstepA = (size_t)HALF * g.lda * 2, hstepB = (size_t)HALF * g.ldb * 2;
    const size_t tstepA = 2 * hstepA, tstepB = 2 * hstepB;
    const unsigned ldsw = (unsigned)wid * 1024u;
    const int aoff = lds_byte(wr * 64 + fr, fq * 8), boff = lds_byte(wc * 32 + fr, fq * 8);
#define PG8_SA(b, h) (((b) * 2 + (h)) * HTB)
#define PG8_SB(b, h) ((4 + (b) * 2 + (h)) * HTB)
#define PG8_STAGE(bufoff, gbase, voff) do { _Pragma("unroll") for (int _i = 0; _i < 2; ++_i) \
        __builtin_amdgcn_global_load_lds((const unsigned*)((const char*)(gbase) + (voff)[_i]), (PG8_LAS unsigned*)(lds + (bufoff) + ldsw + _i * 8192), 16, 0, 0); } while (0)
#define PG8_LDA(dst, b, h) do { _Pragma("unroll") for (int m = 0; m < 4; ++m) _Pragma("unroll") for (int k = 0; k < 2; ++k) dst[m][k] = *(const PG8_LAS bf16x8*)(lds + PG8_SA(b, h) + aoff + m * 2048 + k * 1024); } while (0)
#define PG8_LDB(dst, b, h) do { _Pragma("unroll") for (int n = 0; n < 2; ++n) _Pragma("unroll") for (int k = 0; k < 2; ++k) dst[n][k] = *(const PG8_LAS bf16x8*)(lds + PG8_SB(b, h) + boff + n * 2048 + k * 1024); } while (0)
#define PG8_MMA(ai, bj, At, Bt) do { __builtin_amdgcn_s_setprio(1); _Pragma("unroll") for (int m = 0; m < 4; ++m) _Pragma("unroll") for (int n = 0; n < 2; ++n) _Pragma("unroll") for (int k = 0; k < 2; ++k) \
        acc[ai][bj][m][n] = __builtin_amdgcn_mfma_f32_16x16x32_bf16(Bt[n][k], At[m][k], acc[ai][bj][m][n], 0, 0, 0); __builtin_amdgcn_s_setprio(0); } while (0)
#define PG8_WAIT_V(n) asm volatile("s_waitcnt vmcnt(" #n ")" ::: "memory")
#define PG8_WAIT_L(n) asm volatile("s_waitcnt lgkmcnt(" #n ")" ::: "memory")
#define PG8_BAR __builtin_amdgcn_s_barrier()
#define PG8_SCHED __builtin_amdgcn_sched_barrier(0)
    Unit cur, nxt; int ui = 0;
    if (!S.next(0, cur)) return;
    f32x4 acc[2][2][4][2];
#pragma unroll
    for (int a = 0; a < 2; ++a)
#pragma unroll
        for (int b = 0; b < 2; ++b)
#pragma unroll
            for (int m = 0; m < 4; ++m)
#pragma unroll
                for (int n = 0; n < 2; ++n) acc[a][b][m][n] = (f32x4){0.f, 0.f, 0.f, 0.f};
    bf16x8 At[4][2], B0[2][2], B1[2][2];
    const char* cA = (const char*)g.A + (size_t)cur.pm * tstepA; const char* cB = (const char*)g.Bt + (size_t)cur.pn * tstepB;
    PG8_STAGE(PG8_SB(0, 0), cB, voffB); PG8_STAGE(PG8_SB(0, 1), cB + hstepB, voffB); PG8_STAGE(PG8_SA(0, 0), cA, voffA); PG8_STAGE(PG8_SA(0, 1), cA + hstepA, voffA);
    if (wr == 1) PG8_BAR;
    PG8_WAIT_V(2); PG8_BAR;
    PG8_STAGE(PG8_SB(1, 0), cB + kstep, voffB); PG8_STAGE(PG8_SA(1, 0), cA + kstep, voffA); PG8_STAGE(PG8_SB(1, 1), cB + hstepB + kstep, voffB);
    PG8_WAIT_V(6); PG8_BAR;
    for (;;) {
        const bool has_next = S.next(ui + 1, nxt);
        const char* nA = has_next ? (const char*)g.A + (size_t)nxt.pm * tstepA : cA; const char* nB = has_next ? (const char*)g.Bt + (size_t)nxt.pn * tstepB : cB;
        for (int t = 0; t < nt; t += 2) {
            const bool last = (t == nt - 2);
            const char* a1 = cA + (size_t)(t + 1) * kstep;
            const char* a2 = last ? nA : cA + (size_t)(t + 2) * kstep; const char* b2 = last ? nB : cB + (size_t)(t + 2) * kstep;
            const char* a3 = a2 + kstep; const char* b3 = b2 + kstep;
            PG8_LDB(B0, 0, 0); PG8_LDB(B1, 0, 1); PG8_SCHED; PG8_LDA(At, 0, 0); PG8_STAGE(PG8_SA(1, 1), a1 + hstepA, voffA);
            PG8_WAIT_V(8); PG8_WAIT_L(0); PG8_BAR; PG8_MMA(0, 0, At, B0); PG8_MMA(0, 1, At, B1); PG8_BAR; PG8_SCHED;
            PG8_LDA(At, 0, 1); PG8_STAGE(PG8_SB(0, 0), b2, voffB); PG8_STAGE(PG8_SB(0, 1), b2 + hstepB, voffB); PG8_STAGE(PG8_SA(0, 0), a2, voffA);
            PG8_WAIT_V(8); PG8_WAIT_L(0); PG8_BAR; PG8_MMA(1, 0, At, B0); PG8_MMA(1, 1, At, B1); PG8_BAR; PG8_SCHED;
            PG8_LDB(B0, 1, 0); PG8_LDB(B1, 1, 1); PG8_SCHED; PG8_LDA(At, 1, 0); PG8_STAGE(PG8_SA(0, 1), a2 + hstepA, voffA);
            PG8_WAIT_V(8); PG8_WAIT_L(0); PG8_BAR; PG8_MMA(0, 0, At, B0); PG8_MMA(0, 1, At, B1); PG8_BAR; PG8_SCHED;
            PG8_LDA(At, 1, 1); PG8_STAGE(PG8_SB(1, 0), b3, voffB); PG8_STAGE(PG8_SB(1, 1), b3 + hstepB, voffB); PG8_STAGE(PG8_SA(1, 0), a3, voffA);
            PG8_WAIT_V(8); PG8_WAIT_L(0); PG8_BAR; PG8_MMA(1, 0, At, B0); PG8_MMA(1, 1, At, B1); PG8_BAR; PG8_SCHED;
        }
        if constexpr (ALIGN_EPI) { if (wr == 0) PG8_BAR; }
        E(acc, cur, wr, wc, fr, fq);
        if (!has_next) break;
#pragma unroll
        for (int a = 0; a < 2; ++a)
#pragma unroll
            for (int b = 0; b < 2; ++b)
#pragma unroll
                for (int m = 0; m < 4; ++m)
#pragma unroll
                    for (int n = 0; n < 2; ++n) acc[a][b][m][n] = (f32x4){0.f, 0.f, 0.f, 0.f};
        cur = nxt; cA = nA; cB = nB; ++ui;
        if constexpr (ALIGN_EPI) { if (wr == 1) PG8_BAR; }
    }
    PG8_WAIT_V(0);
    if constexpr (!ALIGN_EPI) { if (wr == 0) PG8_BAR; }
    PG8_BAR;
#undef PG8_SA
#undef PG8_SB
#undef PG8_STAGE
#undef PG8_LDA
#undef PG8_LDB
#undef PG8_MMA
#undef PG8_WAIT_V
#undef PG8_WAIT_L
#undef PG8_BAR
#undef PG8_SCHED
}
}

using pg8::bf16_t; using pg8::f32x4; using pg8::u32x4; using pg8::Unit; using pg8::pack8;
typedef float f32x2v __attribute__((ext_vector_type(2)));

constexpr int DM = 1024, NB = 8, SEQ = 4096, CTXL = 256, NH = 8, LK = SEQ + CTXL;
constexpr int MLAT = NB * SEQ, MCTX = NB * CTXL, MALL = MLAT + MCTX;
constexpr int QLR = 384, KVLR = 256, DIN = 1184, DFF = 2816;
constexpr int S5G = 32, S5P = 64, S5T = 32, NCH = 1280;
constexpr float EPS = 1e-6f;
constexpr float DN_ALPHA = 1.189207115002721f;

constexpr size_t MiB = 1u << 20;
constexpr size_t WS_MODS = 1 * MiB, WS_ROPE = 2 * MiB, WS_AP = 3 * MiB, WS_BBAR = 5 * MiB, WS_KT = 6 * MiB, WS_SS = 8 * MiB;
constexpr size_t WS_WIN = 12 * MiB, WS_WUQ = 15 * MiB, WS_WKV = 16 * MiB, WS_WGLU = 17 * MiB, WS_WOUT = 18 * MiB, WS_WGU = 20 * MiB, WS_WDN = 31 * MiB;
constexpr size_t WS_FM = 37 * MiB, WS_ME = 45 * MiB, WS_XN = 70 * MiB;
constexpr size_t WS_H = 138 * MiB, WS_PQ = 138 * MiB, WS_PKV = 162 * MiB, WS_A2 = 179 * MiB, WS_LB = 239 * MiB, WS_Q = 279 * MiB, WS_K = 327 * MiB, WS_V = 378 * MiB, WS_Z = 412 * MiB, WS_CAT = 444 * MiB, WS_END = 508 * MiB;

struct Params {
    const float* in[29];
    float* out; unsigned char* ws;
};

struct EpiIn {
    static constexpr bool PERM = true;
    bf16_t* PQ; bf16_t* PKV; float* SS; bf16_t* Kb; bf16_t* A2; const f32x2v* rope;
    __device__ __forceinline__ void operator()(const f32x4 (&acc)[2][2][4][2], const Unit& u, int wr, int wc, int fr, int fq) const {
#pragma unroll
        for (int ai = 0; ai < 2; ++ai)
#pragma unroll
            for (int m = 0; m < 4; ++m) {
                const int row = u.pm * 256 + ai * 128 + wr * 64 + m * 16 + fr;
                const bool lat = row < MLAT;
                const int b = lat ? (row >> 12) : ((row - MLAT) >> 8), l = lat ? (row & 4095) : ((row - MLAT) & 255);
#pragma unroll
                for (int bj = 0; bj < 2; ++bj) {
                    const int cseg = u.pn * 256 + bj * 128 + wc * 32, c0 = cseg + 8 * fq;
                    const f32x4 v0 = acc[ai][bj][m][0], v1 = acc[ai][bj][m][1];
                    if (cseg < 640) {
                        float ss = (v0[0] * v0[0] + v0[1] * v0[1]) + (v0[2] * v0[2] + v0[3] * v0[3]) + (v1[0] * v1[0] + v1[1] * v1[1]) + (v1[2] * v1[2] + v1[3] * v1[3]);
                        ss += __shfl_xor(ss, 16); ss += __shfl_xor(ss, 32);
                        if (fq == 0) SS[(size_t)row * 20 + (cseg >> 5)] = ss;
                        const u32x4 w = pack8(v0, v1);
                        if (cseg < QLR) { if (lat) *(u32x4*)(PQ + (size_t)row * QLR + c0) = w; }
                        else *(u32x4*)(PKV + (size_t)row * KVLR + (c0 - QLR)) = w;
                    } else if (cseg < 672) {
                        f32x4 o0 = v0, o1 = v1;
                        if (lat) {
                            const f32x2v* rp = rope + (size_t)l * 16 + 4 * fq;
                            const f32x2v c0_ = rp[0], c1_ = rp[1], c2_ = rp[2], c3_ = rp[3];
                            o0[0] = v0[0] * c0_.x - v0[1] * c0_.y; o0[1] = v0[0] * c0_.y + v0[1] * c0_.x;
                            o0[2] = v0[2] * c1_.x - v0[3] * c1_.y; o0[3] = v0[2] * c1_.y + v0[3] * c1_.x;
                            o1[0] = v1[0] * c2_.x - v1[1] * c2_.y; o1[1] = v1[0] * c2_.y + v1[1] * c2_.x;
                            o1[2] = v1[2] * c3_.x - v1[3] * c3_.y; o1[3] = v1[2] * c3_.y + v1[3] * c3_.x;
                        }
                        const int key = lat ? CTXL + l : l;
                        const u32x4 w = pack8(o0, o1);
#pragma unroll
                        for (int h = 0; h < NH; ++h) *(u32x4*)(Kb + ((size_t)(b * NH + h) * LK + key) * 96 + 64 + 8 * fq) = w;
                    } else if (cseg < DIN) {
                        const int cu = c0 - 672, g = cu >> 4, c = cu & 15;
                        const int n = lat ? b * 128 + (l >> 5) : 1024 + b * 8 + (l >> 5), j = l & 31;
                        *(u32x4*)(A2 + ((size_t)g * NCH + n) * 768 + j * 16 + c) = pack8(v0, v1);
                    }
                }
                asm volatile("" ::: "memory"); __builtin_amdgcn_sched_barrier(0);
            }
    }
};

struct EpiQ {
    static constexpr bool PERM = true;
    bf16_t* Q; const float* SS; const f32x2v* rope;
    __device__ __forceinline__ void operator()(const f32x4 (&acc)[2][2][4][2], const Unit& u, int wr, int wc, int fr, int fq) const {
#pragma unroll
        for (int ai = 0; ai < 2; ++ai)
#pragma unroll
            for (int m = 0; m < 4; ++m) {
                const int row = u.pm * 256 + ai * 128 + wr * 64 + m * 16 + fr, b = row >> 12, l = row & 4095;
                const f32x4* sp = (const f32x4*)(SS + (size_t)row * 20);
                const f32x4 s0 = sp[0], s1 = sp[1], s2 = sp[2];
                const float sum = ((s0[0] + s0[1]) + (s0[2] + s0[3])) + ((s1[0] + s1[1]) + (s1[2] + s1[3])) + ((s2[0] + s2[1]) + (s2[2] + s2[3]));
                const float rs = 1.0f / sqrtf(sum * (1.0f / QLR) + EPS);
#pragma unroll
                for (int bj = 0; bj < 2; ++bj) {
                    const int c0 = u.pn * 256 + bj * 128 + wc * 32 + 8 * fq, h = c0 / 96, e = c0 - h * 96;
                    f32x4 v0 = acc[ai][bj][m][0] * rs, v1 = acc[ai][bj][m][1] * rs;
                    if (e >= 64) {
                        const f32x2v* rp = rope + (size_t)l * 16 + ((e - 64) >> 1);
                        const f32x2v c0_ = rp[0], c1_ = rp[1], c2_ = rp[2], c3_ = rp[3];
                        f32x4 o0, o1;
                        o0[0] = v0[0] * c0_.x - v0[1] * c0_.y; o0[1] = v0[0] * c0_.y + v0[1] * c0_.x;
                        o0[2] = v0[2] * c1_.x - v0[3] * c1_.y; o0[3] = v0[2] * c1_.y + v0[3] * c1_.x;
                        o1[0] = v1[0] * c2_.x - v1[1] * c2_.y; o1[1] = v1[0] * c2_.y + v1[1] * c2_.x;
                        o1[2] = v1[2] * c3_.x - v1[3] * c3_.y; o1[3] = v1[2] * c3_.y + v1[3] * c3_.x;
                        v0 = o0; v1 = o1;
                    }
                    *(u32x4*)(Q + ((size_t)(b * NH + h) * SEQ + l) * 96 + e) = pack8(v0, v1);
                }
                asm volatile("" ::: "memory"); __builtin_amdgcn_sched_barrier(0);
            }
    }
};

struct EpiKV {
    static constexpr bool PERM = true;
    bf16_t* Kb; bf16_t* Vb; const float* SS;
    __device__ __forceinline__ void operator()(const f32x4 (&acc)[2][2][4][2], const Unit& u, int wr, int wc, int fr, int fq) const {
#pragma unroll
        for (int ai = 0; ai < 2; ++ai)
#pragma unroll
            for (int m = 0; m < 4; ++m) {
                const int row = u.pm * 256 + ai * 128 + wr * 64 + m * 16 + fr;
                const bool lat = row < MLAT;
                const int b = lat ? (row >> 12) : ((row - MLAT) >> 8), l = lat ? (row & 4095) : ((row - MLAT) & 255);
                const int key = lat ? CTXL + l : l;
                const f32x4* sp = (const f32x4*)(SS + (size_t)row * 20 + 12);
                const f32x4 s0 = sp[0], s1 = sp[1];
                const float sum = ((s0[0] + s0[1]) + (s0[2] + s0[3])) + ((s1[0] + s1[1]) + (s1[2] + s1[3]));
                const float rs = 1.0f / sqrtf(sum * (1.0f / KVLR) + EPS);
#pragma unroll
                for (int bj = 0; bj < 2; ++bj) {
                    const int c0 = u.pn * 256 + bj * 128 + wc * 32 + 8 * fq;
                    const u32x4 w = pack8(acc[ai][bj][m][0] * rs, acc[ai][bj][m][1] * rs);
                    if (c0 < 512) { const int h = c0 >> 6, e = c0 & 63; *(u32x4*)(Kb + ((size_t)(b * NH + h) * LK + key) * 96 + e) = w; }
                    else { const int c1 = c0 - 512, h = c1 >> 6, e = c1 & 63; *(u32x4*)(Vb + ((size_t)(b * NH + h) * LK + key) * 64 + e) = w; }
                }
                asm volatile("" ::: "memory"); __builtin_amdgcn_sched_barrier(0);
            }
    }
};

struct EpiS1 {
    static constexpr bool PERM = true;
    float* Lb;
    __device__ __forceinline__ void operator()(const f32x4 (&acc)[2][2][4][2], const Unit& u, int wr, int wc, int fr, int fq) const {
#pragma unroll
        for (int ai = 0; ai < 2; ++ai)
#pragma unroll
            for (int m = 0; m < 4; ++m) {
                const int row = u.pm * 256 + ai * 128 + wr * 64 + m * 16 + fr;
#pragma unroll
                for (int bj = 0; bj < 2; ++bj) {
                    float* p = Lb + (size_t)row * 256 + bj * 128 + wc * 32 + 8 * fq;
                    *(f32x4*)p = acc[ai][bj][m][0]; *(f32x4*)(p + 4) = acc[ai][bj][m][1];
                }
            }
    }
};

__device__ __forceinline__ float gelu_tanh(float x) { const float t = 1.5957691216057308f * (x + 0.044715f * x * x * x); return x / (1.0f + __expf(-t)); }
__device__ __forceinline__ float sigmoidf_(float x) { return 1.0f / (1.0f + __expf(-x)); }

struct EpiS2 {
    static constexpr bool PERM = true;
    bf16_t* Z;
    __device__ __forceinline__ void operator()(const f32x4 (&acc)[2][2][4][2], const Unit& u, int wr, int wc, int fr, int fq) const {
        const int g = u.pn >> 1, jn = u.pn & 1, it = u.pm - g * 5;
#pragma unroll
        for (int ai = 0; ai < 2; ++ai)
#pragma unroll
            for (int m = 0; m < 4; ++m) {
                const int n = it * 256 + ai * 128 + wr * 64 + m * 16 + fr, b = n >> 7, j = n & 127;
#pragma unroll
                for (int bj = 0; bj < 2; ++bj) {
                    const int cc = jn * 256 + bj * 128 + wc * 32 + 8 * fq, ti = cc >> 4, c = cc & 15;
                    f32x4 v0 = acc[ai][bj][m][0], v1 = acc[ai][bj][m][1];
#pragma unroll
                    for (int k = 0; k < 4; ++k) { v0[k] = gelu_tanh(v0[k]); v1[k] = gelu_tanh(v1[k]); }
                    *(u32x4*)(Z + ((size_t)b * SEQ + j * 32 + ti) * 512 + g * 16 + c) = pack8(v0, v1);
                }
            }
    }
};

__device__ __forceinline__ float bf_lo(unsigned w) { return __uint_as_float(w << 16); }
__device__ __forceinline__ float bf_hi(unsigned w) { return __uint_as_float(w & 0xffff0000u); }

struct EpiGlu {
    static constexpr bool PERM = true;
    const bf16_t* Z; bf16_t* CAT; const float* bglu;
    __device__ __forceinline__ void operator()(const f32x4 (&acc)[2][2][4][2], const Unit& u, int wr, int wc, int fr, int fq) const {
#pragma unroll
        for (int ai = 0; ai < 2; ++ai)
#pragma unroll
            for (int m = 0; m < 4; ++m) {
                const int row = u.pm * 256 + ai * 128 + wr * 64 + m * 16 + fr;
#pragma unroll
                for (int bj = 0; bj < 2; ++bj) {
                    const int c0 = u.pn * 256 + bj * 128 + wc * 32 + 8 * fq;
                    const u32x4 zw = *(const u32x4*)(Z + (size_t)row * 512 + c0);
                    const f32x4 b0 = *(const f32x4*)(bglu + c0), b1 = *(const f32x4*)(bglu + c0 + 4);
                    const f32x4 a0 = acc[ai][bj][m][0] + b0, a1 = acc[ai][bj][m][1] + b1;
                    f32x4 o0, o1;
                    o0[0] = bf_lo(zw.x) * sigmoidf_(a0[0]); o0[1] = bf_hi(zw.x) * sigmoidf_(a0[1]); o0[2] = bf_lo(zw.y) * sigmoidf_(a0[2]); o0[3] = bf_hi(zw.y) * sigmoidf_(a0[3]);
                    o1[0] = bf_lo(zw.z) * sigmoidf_(a1[0]); o1[1] = bf_hi(zw.z) * sigmoidf_(a1[1]); o1[2] = bf_lo(zw.w) * sigmoidf_(a1[2]); o1[3] = bf_hi(zw.w) * sigmoidf_(a1[3]);
                    *(u32x4*)(CAT + (size_t)row * DM + 512 + c0) = pack8(o0, o1);
                }
                asm volatile("" ::: "memory"); __builtin_amdgcn_sched_barrier(0);
            }
    }
};

struct EpiRes {
    static constexpr bool PERM = true;
    const float* base; float* out; const float* gate;
    __device__ __forceinline__ void operator()(const f32x4 (&acc)[2][2][4][2], const Unit& u, int wr, int wc, int fr, int fq) const {
#pragma unroll
        for (int ai = 0; ai < 2; ++ai)
#pragma unroll
            for (int m = 0; m < 4; ++m) {
                const int row = u.pm * 256 + ai * 128 + wr * 64 + m * 16 + fr, b = row >> 12;
#pragma unroll
                for (int bj = 0; bj < 2; ++bj) {
                    const int c0 = u.pn * 256 + bj * 128 + wc * 32 + 8 * fq;
                    const float* gp = gate + (size_t)b * 6144 + c0; const float* bp = base + (size_t)row * DM + c0; float* op = out + (size_t)row * DM + c0;
                    const f32x4 g0 = *(const f32x4*)gp, g1 = *(const f32x4*)(gp + 4), x0 = *(const f32x4*)bp, x1 = *(const f32x4*)(bp + 4);
                    *(f32x4*)op = x0 * DN_ALPHA + g0 * acc[ai][bj][m][0]; *(f32x4*)(op + 4) = x1 * DN_ALPHA + g1 * acc[ai][bj][m][1];
                }
                asm volatile("" ::: "memory"); __builtin_amdgcn_sched_barrier(0);
            }
    }
};

struct EpiGU {
    static constexpr bool PERM = true;
    bf16_t* H;
    __device__ __forceinline__ void operator()(const f32x4 (&acc)[2][2][4][2], const Unit& u, int wr, int wc, int fr, int fq) const {
#pragma unroll
        for (int ai = 0; ai < 2; ++ai)
#pragma unroll
            for (int m = 0; m < 4; ++m) {
                const int row = u.pm * 256 + ai * 128 + wr * 64 + m * 16 + fr;
                const f32x4 g0 = acc[ai][0][m][0], g1 = acc[ai][0][m][1], u0 = acc[ai][1][m][0], u1 = acc[ai][1][m][1];
                f32x4 o0, o1;
#pragma unroll
                for (int k = 0; k < 4; ++k) { o0[k] = g0[k] * sigmoidf_(g0[k]) * u0[k]; o1[k] = g1[k] * sigmoidf_(g1[k]) * u1[k]; }
                *(u32x4*)(H + (size_t)row * DFF + u.pn * 128 + wc * 32 + 8 * fq) = pack8(o0, o1);
            }
    }
};

struct SchedS1 { int G, c;
    __device__ bool next(int i, Unit& u) const { const int L = i * G + c; if (L >= S5G * 5) return false; u.pm = L; u.pn = L / 5; return true; } };
struct SchedS2 { int G, c;
    __device__ bool next(int i, Unit& u) const { const int L = i * G + c; if (L >= S5G * 8) return false; const int g = L >> 3, r = L & 7; u.pm = g * 5 + (r >> 1); u.pn = g * 2 + (r & 1); return true; } };

namespace att {
using bf16x8 = __attribute__((ext_vector_type(8))) short;
using s16x4 = __attribute__((ext_vector_type(4))) short;
using f32x16 = __attribute__((ext_vector_type(16))) float;
constexpr int NW = 8, QBLK = 32, KVBLK = 64;
constexpr float SCALE = 0.10206207261596577f;
constexpr float THR = 8.f;
constexpr int SHM_V = KVBLK * 64 * 2, SHM_K = KVBLK * 256;
#define KSWZ(row, colB) ((row) * 256 + ((colB) ^ (((row) & 7) << 4)))
#define SBAR() __builtin_amdgcn_sched_barrier(0)
__device__ __forceinline__ int crow(int r, int hi) { return (r & 3) + 8 * (r >> 2) + 4 * hi; }
__device__ __forceinline__ unsigned cvtpk(float lo, float hi) { unsigned r; asm volatile("v_cvt_pk_bf16_f32 %0, %1, %2" : "=v"(r) : "v"(lo), "v"(hi)); return r; }

__device__ __forceinline__ void partialSM(f32x16& p0, f32x16& p1, float& m_reg, float& mn, float& alpha) {
  constexpr float C = SCALE * 1.4426950408889634f;
  float pmax = p0[0];
#pragma unroll
  for (int r = 1; r < 16; ++r) pmax = fmaxf(pmax, p0[r]);
#pragma unroll
  for (int r = 0; r < 16; ++r) pmax = fmaxf(pmax, p1[r]);
  { auto rr = __builtin_amdgcn_permlane32_swap(__float_as_uint(pmax), __float_as_uint(pmax), false, false);
    pmax = fmaxf(__uint_as_float(rr[0]), __uint_as_float(rr[1])); }
  if (__builtin_expect(__all(pmax - m_reg <= THR / SCALE), 1)) { mn = m_reg; alpha = 1.f; }
  else { mn = fmaxf(m_reg, pmax); alpha = __builtin_amdgcn_exp2f((m_reg - mn) * C); m_reg = mn; }
  float mnC = -mn * C;
#pragma unroll
  for (int r = 0; r < 16; ++r) p0[r] = fmaf(p0[r], C, mnC);
#pragma unroll
  for (int r = 0; r < 16; ++r) p1[r] = fmaf(p1[r], C, mnC);
#pragma unroll
  for (int r = 0; r < 16; ++r) p0[r] = __builtin_amdgcn_exp2f(p0[r]);
}
__device__ __forceinline__ void finishSM(f32x16& p0, f32x16& p1, float alpha, float& l_reg, bf16x8& pa0, bf16x8& pa1, bf16x8& pa2, bf16x8& pa3) {
#pragma unroll
  for (int r = 0; r < 16; ++r) p1[r] = __builtin_amdgcn_exp2f(p1[r]);
  float ps = 0;
#pragma unroll
  for (int r = 0; r < 16; ++r) ps += p0[r];
#pragma unroll
  for (int r = 0; r < 16; ++r) ps += p1[r];
  { auto rr = __builtin_amdgcn_permlane32_swap(__float_as_uint(ps), __float_as_uint(ps), false, false);
    ps = __uint_as_float(rr[0]) + __uint_as_float(rr[1]); }
  l_reg = l_reg * alpha + ps;
#define PK4(P, BASE, OUT) do { unsigned a0 = cvtpk(P[BASE + 0], P[BASE + 1]), a1 = cvtpk(P[BASE + 2], P[BASE + 3]);   \
    unsigned b0 = cvtpk(P[BASE + 4], P[BASE + 5]), b1 = cvtpk(P[BASE + 6], P[BASE + 7]);                              \
    auto r0 = __builtin_amdgcn_permlane32_swap(a0, b0, false, false); auto r1 = __builtin_amdgcn_permlane32_swap(a1, b1, false, false); \
    u32x4 w = {r0[0], r1[0], r0[1], r1[1]}; OUT = *reinterpret_cast<bf16x8*>(&w); } while (0)
  PK4(p0, 0, pa0); PK4(p0, 8, pa1); PK4(p1, 0, pa2); PK4(p1, 8, pa3);
#undef PK4
}
__device__ __forceinline__ void qkt(f32x16& p0, f32x16& p1, const char* Ks, const bf16x8* qr, int r32, int hi) {
  p0 = f32x16{}; p1 = f32x16{};
#pragma unroll
  for (int d0 = 0; d0 < 6; ++d0) { const int cb = (d0 * 16 + hi * 8) * 2;
    bf16x8 b0 = *reinterpret_cast<const bf16x8*>(Ks + KSWZ(r32, cb));
    bf16x8 b1 = *reinterpret_cast<const bf16x8*>(Ks + KSWZ(32 + r32, cb));
    p0 = __builtin_amdgcn_mfma_f32_32x32x16_bf16(b0, qr[d0], p0, 0, 0, 0);
    p1 = __builtin_amdgcn_mfma_f32_32x32x16_bf16(b1, qr[d0], p1, 0, 0, 0); }
}
__device__ __forceinline__ int v_st(int k, int c) { const int kk = (k & ~0xC) | ((k & 4) << 1) | ((k & 8) >> 1); return ((kk >> 3) * 2 + (c >> 5)) * 512 + ((kk & 7) * 32 + (c & 31)) * 2; }
__device__ __forceinline__ int v_rd_base(int lane) { return ((lane & 3) << 3) | (((lane >> 2) & 3) << 6) | (((lane >> 4) & 1) << 5) | (((lane >> 5) & 1) << 8); }
constexpr int v_rd_off(int d0, int ks, int half) { return d0 * 512 + ks * 2048 + half * 1024; }
template <int OFF> __device__ __forceinline__ s16x4 tr_read(int vb) {
  s16x4 r; asm volatile("ds_read_b64_tr_b16 %0, %1 offset:%2" : "=&v"(r) : "v"(vb), "i"(OFF) : "memory"); return r;
}
template <int D0> __device__ __forceinline__ void pv_one(f32x16& od, int vb, bf16x8 pa0, bf16x8 pa1, bf16x8 pa2, bf16x8 pa3) {
  const s16x4 l0 = tr_read<v_rd_off(D0, 0, 0)>(vb), h0 = tr_read<v_rd_off(D0, 0, 1)>(vb), l1 = tr_read<v_rd_off(D0, 1, 0)>(vb), h1 = tr_read<v_rd_off(D0, 1, 1)>(vb);
  const s16x4 l2 = tr_read<v_rd_off(D0, 2, 0)>(vb), h2 = tr_read<v_rd_off(D0, 2, 1)>(vb), l3 = tr_read<v_rd_off(D0, 3, 0)>(vb), h3 = tr_read<v_rd_off(D0, 3, 1)>(vb);
  asm volatile("s_waitcnt lgkmcnt(0)" ::: "memory"); SBAR();
#define PK(L, H) (bf16x8){L[0], L[1], L[2], L[3], H[0], H[1], H[2], H[3]}
  od = __builtin_amdgcn_mfma_f32_32x32x16_bf16(pa0, PK(l0, h0), od, 0, 0, 0);
  od = __builtin_amdgcn_mfma_f32_32x32x16_bf16(pa1, PK(l1, h1), od, 0, 0, 0);
  od = __builtin_amdgcn_mfma_f32_32x32x16_bf16(pa2, PK(l2, h2), od, 0, 0, 0);
  od = __builtin_amdgcn_mfma_f32_32x32x16_bf16(pa3, PK(l3, h3), od, 0, 0, 0);
#undef PK
}
__device__ __forceinline__ void pv_d0(f32x16* o, int vb, bf16x8 pa0, bf16x8 pa1, bf16x8 pa2, bf16x8 pa3) {
  pv_one<0>(o[0], vb, pa0, pa1, pa2, pa3); pv_one<1>(o[1], vb, pa0, pa1, pa2, pa3);
}

__device__ __forceinline__ void attn_unit(const bf16_t* __restrict__ Qb, const bf16_t* __restrict__ Kh, const bf16_t* __restrict__ Vh, bf16_t* __restrict__ Ob, char* lds) {
  int tid_ = threadIdx.x; asm volatile("" : "+v"(tid_));
  const int tid = tid_, wid = tid >> 6, lane = tid & 63, r32 = lane & 31, hi = lane >> 5;
  char* V_lds = lds; char* K_lds = lds + 2 * SHM_V;
  float* ws = (float*)(lds + 2 * SHM_V + 2 * SHM_K) + wid * 64; float* li_l = ws; float* al_l = ws + 32;
  float m_reg = -1e30f, l_reg = 0; f32x16 o[2] = {}; bf16x8 qr[6];
  const bf16_t* Qw = Qb + (size_t)(wid * QBLK + r32) * 96 + hi * 8;
#pragma unroll
  for (int d0 = 0; d0 < 6; ++d0) qr[d0] = *reinterpret_cast<const bf16x8*>(Qw + d0 * 16);
  const int kc0 = tid, kc1 = 512 + (tid & 255);
  const int kst0 = KSWZ(kc0 / 12, (kc0 % 12) * 16), kst1 = KSWZ(kc1 / 12, (kc1 % 12) * 16);
  const int vst0 = v_st(tid >> 3, (tid & 7) * 8);
  const int vb0 = (int)(uintptr_t)V_lds + v_rd_base(lane);
  const char* Kg = (const char*)Kh; const char* Vg = (const char*)Vh;
  struct { bf16x8 k0, k1, v0; } sr_[2];
#define SLOAD(i, t) do { const char* kb_ = Kg + (size_t)(t) * 12288; const char* vb_ = Vg + (size_t)(t) * 8192; \
    sr_[i].k0 = *reinterpret_cast<const bf16x8*>(kb_ + kc0 * 16); sr_[i].k1 = *reinterpret_cast<const bf16x8*>(kb_ + kc1 * 16); sr_[i].v0 = *reinterpret_cast<const bf16x8*>(vb_ + tid * 16); } while (0)
#define SWRITE(b, i) do { *(bf16x8*)(V_lds + (b) * SHM_V + vst0) = sr_[i].v0; *(bf16x8*)(K_lds + (b) * SHM_K + kst0) = sr_[i].k0; \
    if (wid < 4) *(bf16x8*)(K_lds + (b) * SHM_K + kst1) = sr_[i].k1; } while (0)
#define SWAIT() asm volatile("s_waitcnt vmcnt(3)" ::: "memory")
#define RESC(a) do { if (__any((a) < 1.f)) { if (hi == 0) al_l[r32] = (a); asm volatile("s_waitcnt lgkmcnt(0)" ::: "memory"); \
    _Pragma("unroll") for (int d = 0; d < 2; ++d) _Pragma("unroll") for (int r = 0; r < 16; ++r) o[d][r] *= al_l[crow(r, hi)]; } } while (0)
  f32x16 pA0, pA1, pB0, pB1; float mnA, mnB, alA, alB; bf16x8 pa0, pa1, pa2, pa3; constexpr int NT = LK / KVBLK;
  SLOAD(0, 0); asm volatile("s_waitcnt vmcnt(0)" ::: "memory"); SWRITE(0, 0); __syncthreads();
  qkt(pA0, pA1, K_lds, qr, r32, hi); partialSM(pA0, pA1, m_reg, mnA, alA);
  SLOAD(1, 1); SLOAD(0, 2);
  SWAIT(); SWRITE(1, 1); __syncthreads();
  for (int j = 1; j + 1 < NT; j += 2) {
    SBAR(); qkt(pB0, pB1, K_lds + SHM_K, qr, r32, hi);
    finishSM(pA0, pA1, alA, l_reg, pa0, pa1, pa2, pa3); SBAR();
    SLOAD(1, j + 2); SBAR();
    pv_d0(o, vb0, pa0, pa1, pa2, pa3); partialSM(pB0, pB1, m_reg, mnB, alB);
    __syncthreads(); SWAIT(); SWRITE(0, 0);
    RESC(alB); __syncthreads();
    SBAR(); qkt(pA0, pA1, K_lds, qr, r32, hi);
    finishSM(pB0, pB1, alB, l_reg, pa0, pa1, pa2, pa3); SBAR();
    if (j + 3 < NT) SLOAD(0, j + 3); SBAR();
    pv_d0(o, vb0 + SHM_V, pa0, pa1, pa2, pa3); partialSM(pA0, pA1, m_reg, mnA, alA);
    __syncthreads(); SWAIT(); SWRITE(1, 1);
    RESC(alA); __syncthreads();
  }
  SBAR(); qkt(pB0, pB1, K_lds + SHM_K, qr, r32, hi);
  finishSM(pA0, pA1, alA, l_reg, pa0, pa1, pa2, pa3); SBAR();
  pv_d0(o, vb0, pa0, pa1, pa2, pa3); partialSM(pB0, pB1, m_reg, mnB, alB);
  __syncthreads(); RESC(alB);
  finishSM(pB0, pB1, alB, l_reg, pa0, pa1, pa2, pa3); SBAR();
  pv_d0(o, vb0 + SHM_V, pa0, pa1, pa2, pa3);
  if (hi == 0) li_l[r32] = l_reg; asm volatile("s_waitcnt lgkmcnt(0)" ::: "memory");
  float rli[16];
#pragma unroll
  for (int r = 0; r < 16; ++r) rli[r] = __builtin_amdgcn_rcpf(li_l[crow(r, hi)]);
  bf16_t* Ow = Ob + (size_t)(wid * QBLK) * DM;
#pragma unroll
  for (int r = 0; r < 16; ++r) { const int orow = crow(r, hi);
#pragma unroll
    for (int d0 = 0; d0 < 2; ++d0) { const unsigned w = cvtpk(o[d0][r] * rli[r], 0.f); Ow[(size_t)orow * DM + d0 * 32 + r32] = (bf16_t)(w & 0xffffu); } }
  __syncthreads();
#undef SLOAD
#undef SWRITE
#undef SWAIT
#undef RESC
}
#undef SBAR
}

#define LAS __attribute__((address_space(3)))
__device__ __forceinline__ float wave_sum(float v) {
#pragma unroll
    for (int o = 1; o < 64; o <<= 1) v += __shfl_xor(v, o);
    return v;
}
__device__ __forceinline__ unsigned pk2(float lo, float hi) { return pg8::cvt_pk_bf16(lo, hi); }

__device__ __forceinline__ void transpose_item(const float* W, int N, bf16_t* WT, int ldt, int k0, int n0, int drow0, const float* kscale, float* scr, int lane) {
#pragma unroll
    for (int i = 0; i < 32; ++i) { const int kk = 2 * i + (lane >> 5); float v = W[(size_t)(k0 + kk) * N + n0 + (lane & 31)]; if (kscale) v *= kscale[k0 + kk]; scr[kk * 33 + (lane & 31)] = v; }
    asm volatile("s_waitcnt lgkmcnt(0)" ::: "memory");
    const int c = lane & 7;
#pragma unroll
    for (int j = 0; j < 4; ++j) { const int n = (lane >> 3) + 8 * j; const float* s = scr + (8 * c) * 33 + n;
        u32x4 o; o.x = pk2(s[0 * 33], s[1 * 33]); o.y = pk2(s[2 * 33], s[3 * 33]); o.z = pk2(s[4 * 33], s[5 * 33]); o.w = pk2(s[6 * 33], s[7 * 33]);
        *(u32x4*)(WT + (size_t)(drow0 + n) * ldt + k0 + 8 * c) = o; }
    asm volatile("s_waitcnt lgkmcnt(0)" ::: "memory");
}

__device__ __forceinline__ void row_stats(const f32x4 (&v)[4], float& mean, float& rstd) {
    float s = 0.f;
#pragma unroll
    for (int j = 0; j < 4; ++j) s += (v[j][0] + v[j][1]) + (v[j][2] + v[j][3]);
    mean = wave_sum(s) * (1.f / DM); float s2 = 0.f;
#pragma unroll
    for (int j = 0; j < 4; ++j) { const f32x4 d = v[j] - mean; s2 += (d[0] * d[0] + d[1] * d[1]) + (d[2] * d[2] + d[3] * d[3]); }
    rstd = 1.f / sqrtf(wave_sum(s2) * (1.f / DM) + EPS);
}


#define XB_TMO      128
#define XB_XCNT(j)  (256  + 64 * (j))
#define XB_XSUB(j)  (1280 + 64 * (j))
#define XB_XGEN(j)  (2304 + 64 * (j))
#define XB_TOP      3328
#define XB_TOPGEN   3392
#define XCD_BAR_WORDS 3456
#define XB_SPIN_CAP (1u << 22)
__device__ __forceinline__ unsigned xb_ld(unsigned* p)              { return __hip_atomic_load(p, __ATOMIC_RELAXED, __HIP_MEMORY_SCOPE_AGENT); }
__device__ __forceinline__ unsigned xb_add(unsigned* p, unsigned v) { return __hip_atomic_fetch_add(p, v, __ATOMIC_RELAXED, __HIP_MEMORY_SCOPE_AGENT); }
__device__ __forceinline__ unsigned xb_xcc_id() { return (unsigned)__builtin_amdgcn_s_getreg((3 << 11) | 20) & 0xFu; }
#define XB_SPIN(cond, bar) do { unsigned _sp = 0; while (cond) { __builtin_amdgcn_s_sleep(1); \
    if ((++_sp & 255u) == 0u) { if (xb_ld(&(bar)[XB_TMO])) break; if (_sp > XB_SPIN_CAP) { atomicAdd(&(bar)[XB_TMO], 1u); break; } } } } while (0)
struct XcdBarrier { unsigned* bar; unsigned x; volatile LAS unsigned* st; };
__device__ __forceinline__ XcdBarrier xcd_barrier_post(unsigned* bar, volatile LAS unsigned* st) {
    XcdBarrier b; b.bar = bar; b.x = xb_xcc_id(); b.st = st;
    if (threadIdx.x == 0) (void)xb_add(&bar[XB_XCNT(b.x)], 1u);
    return b;
}
__device__ __forceinline__ void xcd_barrier_complete(unsigned* bar, unsigned x, unsigned& nloc, unsigned& nx) {
    const unsigned G = gridDim.x * gridDim.y * gridDim.z;
    unsigned sum, cnt, mine, sp = 0u;
    for (;;) {
        sum = 0u; cnt = 0u; mine = 0u;
#pragma unroll
        for (unsigned j = 0; j < 16; ++j) { const unsigned c = xb_ld(&bar[XB_XCNT(j)]); sum += c; cnt += (c > 0u) ? 1u : 0u; mine = (j == x) ? c : mine; }
        if (sum == G) break;
        __builtin_amdgcn_s_sleep(1);
        if ((++sp & 255u) == 0u) { if (xb_ld(&bar[XB_TMO])) break; if (sp > XB_SPIN_CAP) { atomicAdd(&bar[XB_TMO], 1u); break; } }
    }
    nloc = mine > 0u ? mine : 1u; nx = cnt > 0u ? cnt : 1u;
}
__device__ __forceinline__ void xcd_barrier(const XcdBarrier& b) {
    asm volatile("s_waitcnt vmcnt(0)" ::: "memory");
    __syncthreads();
    if (threadIdx.x == 0) {
        unsigned* bar = b.bar;
        __builtin_amdgcn_s_waitcnt(0);
        unsigned nloc = b.st[0], nx = b.st[1];
        if (nloc == 0u) { xcd_barrier_complete(bar, b.x, nloc, nx); b.st[0] = nloc; b.st[1] = nx; }
        const unsigned old = xb_add(&bar[XB_XSUB(b.x)], 1u);
        const unsigned gen = old / nloc;
        if (old + 1u == (gen + 1u) * nloc) {
            __builtin_amdgcn_fence(__ATOMIC_RELEASE, "agent");
            asm volatile("s_waitcnt vmcnt(0)" ::: "memory");
            const unsigned og = xb_add(&bar[XB_TOP], 1u);
            const unsigned tg = og / nx;
            if (og + 1u == (tg + 1u) * nx) xb_add(&bar[XB_TOPGEN], 1u);
            else XB_SPIN(xb_ld(&bar[XB_TOPGEN]) == tg, bar);
            __builtin_amdgcn_fence(__ATOMIC_ACQUIRE, "agent");
            xb_add(&bar[XB_XGEN(b.x)], 1u);
            asm volatile("s_waitcnt vmcnt(0)" ::: "memory");
        } else {
            XB_SPIN(xb_ld(&bar[XB_XGEN(b.x)]) == gen, bar);
            __builtin_amdgcn_fence(__ATOMIC_ACQUIRE, "agent");
            asm volatile("s_waitcnt vmcnt(0)" ::: "memory");
        }
    }
    __syncthreads();
}
#ifndef PHASES
#define PHASES 0xFFF
#endif
constexpr int NWAVES = 8, NTHREADS = 512, LDS_BYTES = 147456;

__global__ void __launch_bounds__(NTHREADS, 2) hymba_fwd(Params P) {
    extern __shared__ __attribute__((aligned(16))) unsigned char lds[];
    cg::grid_group grid = cg::this_grid();
    const int G = gridDim.x, bx = blockIdx.x;
    const int vcu = (G % 8 == 0) ? (bx % 8) * (G / 8) + bx / 8 : bx;
    const int NGW = G * NWAVES; const long NGT = (long)G * NTHREADS;
#define PHASE_IDS int tid_ = threadIdx.x; asm volatile("" : "+v"(tid_)); const int tid = tid_, lane = tid & 63, wave = __builtin_amdgcn_readfirstlane(tid >> 6); \
    const int gw = vcu * NWAVES + wave; const long gt = (long)bx * NTHREADS + tid; (void)lane; (void)gw; (void)gt;
    unsigned char* ws = P.ws;
    const float* x = P.in[0]; const float* cnd = P.in[1]; const float* ctx = P.in[2]; const float* cctx = P.in[3];
    const float* w_ada = P.in[4]; const float* b_ada = P.in[5];
    float* mods = (float*)(ws + WS_MODS); f32x2v* rope = (f32x2v*)(ws + WS_ROPE); f32x2v* AP = (f32x2v*)(ws + WS_AP); f32x2v* BBAR = (f32x2v*)(ws + WS_BBAR);
    float* KT = (float*)(ws + WS_KT); float* SS = (float*)(ws + WS_SS);
    bf16_t* WIN = (bf16_t*)(ws + WS_WIN); bf16_t* WUQ = (bf16_t*)(ws + WS_WUQ); bf16_t* WKV = (bf16_t*)(ws + WS_WKV); bf16_t* WGLU = (bf16_t*)(ws + WS_WGLU);
    bf16_t* WOUT = (bf16_t*)(ws + WS_WOUT); bf16_t* WGU = (bf16_t*)(ws + WS_WGU); bf16_t* WDN = (bf16_t*)(ws + WS_WDN);
    bf16_t* FM = (bf16_t*)(ws + WS_FM); bf16_t* ME = (bf16_t*)(ws + WS_ME); bf16_t* XN = (bf16_t*)(ws + WS_XN);
    bf16_t* HB = (bf16_t*)(ws + WS_H); bf16_t* PQ = (bf16_t*)(ws + WS_PQ); bf16_t* PKV = (bf16_t*)(ws + WS_PKV); bf16_t* A2 = (bf16_t*)(ws + WS_A2);
    float* LB = (float*)(ws + WS_LB); bf16_t* Qb = (bf16_t*)(ws + WS_Q); bf16_t* Kb = (bf16_t*)(ws + WS_K); bf16_t* Vb = (bf16_t*)(ws + WS_V);
    bf16_t* Zb = (bf16_t*)(ws + WS_Z); bf16_t* CAT = (bf16_t*)(ws + WS_CAT);
    PG8_LAS unsigned char* ldsl = (PG8_LAS unsigned char*)lds;
    volatile LAS unsigned* MISC = (volatile LAS unsigned*)(ldsl + 131072 + 512);
    if (threadIdx.x < 8) MISC[threadIdx.x] = 0u;
    if (bx == 0) for (int i = threadIdx.x; i < XCD_BAR_WORDS; i += NTHREADS) ((unsigned*)ws)[i] = 0u;

    if (PHASES & (1 << 0)) {
    PHASE_IDS
    if (bx < 192) {
        float* sc = (float*)lds;
        float* red = (float*)lds + 9 * 1024;
        for (int i = tid; i < 9 * 1024; i += NTHREADS) { const int r = i >> 10, k = i & 1023; const float v = r < 8 ? cnd[r * 1024 + k] : cctx[k]; sc[i] = v / (1.f + __expf(-v)); }
        __syncthreads();
        const int j = tid & 31, kk = tid >> 5, col = bx * 32 + j;
        float a[9];
#pragma unroll
        for (int r = 0; r < 9; ++r) a[r] = 0.f;
        for (int k0 = kk; k0 < 1024; k0 += 256) {
            float w[16];
#pragma unroll
            for (int q = 0; q < 16; ++q) w[q] = w_ada[(size_t)(k0 + 16 * q) * 6144 + col];
#pragma unroll
            for (int q = 0; q < 16; ++q)
#pragma unroll
                for (int r = 0; r < 9; ++r) a[r] += sc[r * 1024 + k0 + 16 * q] * w[q];
        }
#pragma unroll
        for (int r = 0; r < 9; ++r) red[(kk * 9 + r) * 32 + j] = a[r];
        __syncthreads();
        if (tid < 288) { const int r = tid >> 5, jj = tid & 31; float s = 0.f;
#pragma unroll
            for (int q = 0; q < 16; ++q) s += red[(q * 9 + r) * 32 + jj];
            mods[r * 6144 + bx * 32 + jj] = s + b_ada[bx * 32 + jj]; }
        __syncthreads();
    }
    {
        float* scr = (float*)(lds + wave * 16384);
        constexpr int NITEMS = 592 + 144 + 64 + 64 + 128 + 512 + 2816 + 1408;
        for (int it = gw; it < NITEMS; it += NGW) {
            int r = it;
            if (r < 592) { const int kb = r / 37, nb = r % 37; transpose_item(P.in[6], DIN, WIN, 1024, 64 * kb, 32 * nb, 32 * nb, nullptr, scr, lane); continue; } r -= 592;
            if (r < 144) { const int kb = r / 24, nb = r % 24; transpose_item(P.in[9], 768, WUQ, QLR, 64 * kb, 32 * nb, 32 * nb, P.in[7], scr, lane); continue; } r -= 144;
            if (r < 64) { const int kb = r / 16, nb = r % 16; transpose_item(P.in[10], 512, WKV, KVLR, 64 * kb, 32 * nb, 32 * nb, P.in[8], scr, lane); continue; } r -= 64;
            if (r < 64) { const int kb = r / 16, nb = r % 16; transpose_item(P.in[11], 512, WKV, KVLR, 64 * kb, 32 * nb, 512 + 32 * nb, P.in[8], scr, lane); continue; } r -= 64;
            if (r < 128) { const int kb = r / 16, nb = r % 16; transpose_item(P.in[20], 512, WGLU, 512, 64 * kb, 32 * nb, 32 * nb, nullptr, scr, lane); continue; } r -= 128;
            if (r < 512) { const int kb = r / 32, nb = r % 32; transpose_item(P.in[22], 1024, WOUT, 1024, 64 * kb, 32 * nb, 32 * nb, nullptr, scr, lane); continue; } r -= 512;
            if (r < 2816) { const int kb = r / 176, nb = r % 176, n0 = 32 * nb; const int n1 = n0 < DFF ? n0 : n0 - DFF; const int dr = (n1 >> 7) * 256 + (n1 & 127) + (n0 < DFF ? 0 : 128);
                transpose_item(P.in[25], 2 * DFF, WGU, 1024, 64 * kb, n0, dr, nullptr, scr, lane); continue; } r -= 2816;
            { const int kb = r / 32, nb = r % 32; transpose_item(P.in[26], 1024, WDN, DFF, 64 * kb, 32 * nb, 32 * nb, nullptr, scr, lane); }
        }
    }
    for (long i = gt; i < 96 * 1024 / 8; i += NGT) *(u32x4*)(WIN + (size_t)DIN * 1024 + i * 8) = (u32x4){0u, 0u, 0u, 0u};
    for (long i = gt; i < SEQ * 16; i += NGT) {
        const int l = (int)(i >> 4), pi = (int)(i & 15), f = pi & 7; const double pos = pi < 8 ? (double)(l >> 6) : (double)(l & 63);
        const double ang = pos * pow(10000.0, -(double)f / 8.0);
        rope[i] = (f32x2v){(float)cos(ang), (float)sin(ang)};
    }
    for (long i = gt; i < S5G * 2 * S5P * 33; i += NGT) {
        const int d = (int)(i % 33); const int r = (int)(i / 33), p = r & 63, dir = (r >> 6) & 1, g = r >> 7;
        const int li = (dir * S5G + g) * S5P + p;
        const double dt = exp((double)P.in[14][dir * S5G + g]), lr = (double)P.in[12][li], lim = (double)P.in[13][li];
        const double mag = exp(lr * dt * d), ang = lim * dt * d;
        AP[i] = (f32x2v){(float)(mag * cos(ang)), (float)(mag * sin(ang))};
    }
    for (long i = gt; i < S5G * 2 * S5P; i += NGT) {
        const int p = (int)(i & 63), dir = (int)((i >> 6) & 1), g = (int)(i >> 7);
        const int li = (dir * S5G + g) * S5P + p;
        const double dt = exp((double)P.in[14][dir * S5G + g]), lr = (double)P.in[12][li], lim = (double)P.in[13][li];
        const double mag = exp(lr * dt), are = mag * cos(lim * dt), aim = mag * sin(lim * dt), den = lr * lr + lim * lim;
        const double fre = ((are - 1.0) * lr + aim * lim) / den, fim = (aim * lr - (are - 1.0) * lim) / den;
#pragma unroll 4
        for (int c = 0; c < 16; ++c) { const double br = (double)P.in[15][(size_t)li * 16 + c], bi = (double)P.in[16][(size_t)li * 16 + c];
            BBAR[i * 16 + c] = (f32x2v){(float)(fre * br - fim * bi), (float)(fre * bi + fim * br)}; }
    }
    }
    grid.sync();
    const XcdBarrier xbar = xcd_barrier_post((unsigned*)ws, MISC);

    if (PHASES & (1 << 1)) {
    PHASE_IDS
    for (int row = gw; row < MALL; row += NGW) {
        const bool latr = row < MLAT; const float* src = latr ? x + (size_t)row * DM : ctx + (size_t)(row - MLAT) * DM; const int r = latr ? (row >> 12) : 8;
        const f32x4* xr = (const f32x4*)src + lane; f32x4 v[4];
#pragma unroll
        for (int j = 0; j < 4; ++j) v[j] = xr[64 * j];
        float mean, rstd; row_stats(v, mean, rstd);
        const f32x4* sh = (const f32x4*)(mods + r * 6144) + lane; const f32x4* scl = (const f32x4*)(mods + r * 6144 + 1024) + lane;
        unsigned long long* o8 = (unsigned long long*)(XN + (size_t)row * DM) + lane;
#pragma unroll
        for (int j = 0; j < 4; ++j) { const f32x4 s_ = sh[64 * j], c_ = scl[64 * j]; const f32x4 y = (v[j] - mean) * rstd * (c_ + 1.0f) + s_;
            o8[64 * j] = (unsigned long long)pk2(y[0], y[1]) | ((unsigned long long)pk2(y[2], y[3]) << 32); }
    }
    for (long i = gt; i < (long)S5G * 256 * 64; i += NGT) {
        const int c8 = (int)(i & 1), j = (int)((i >> 1) & 31), r = (int)((i >> 6) & 255), g = (int)(i >> 14);
        const int ri = r & 1, p = (r >> 1) & 63, dir = r >> 7;
        const int ab = ((g * 2 + dir) * S5P + p);
        const f32x2v a = AP[ab * 33 + (dir == 0 ? 31 - j : j)];
        float o[8];
#pragma unroll
        for (int c = 0; c < 8; ++c) { const f32x2v bb = BBAR[(size_t)ab * 16 + c8 * 8 + c]; o[c] = ri == 0 ? a.x * bb.x - a.y * bb.y : a.x * bb.y + a.y * bb.x; }
        u32x4 w; w.x = pk2(o[0], o[1]); w.y = pk2(o[2], o[3]); w.z = pk2(o[4], o[5]); w.w = pk2(o[6], o[7]);
        *(u32x4*)(FM + ((size_t)g * 256 + r) * 512 + j * 16 + c8 * 8) = w;
    }
    for (long i = gt; i < (long)S5G * 512 * 32; i += NGT) {
        const int q = (int)(i & 31), rr = (int)((i >> 5) & 511), g = (int)(i >> 14);
        const int dir = q >> 4, p0 = (q & 15) * 4, ti = rr >> 4, co = rr & 15;
        float o[8];
#pragma unroll
        for (int k = 0; k < 4; ++k) { const int p = p0 + k; const size_t ci = ((size_t)(dir * S5G + g) * 16 + co) * S5P + p;
            const float cr = P.in[17][ci], cim = P.in[18][ci];
            const f32x2v a = AP[((g * 2 + dir) * S5P + p) * 33 + (dir == 0 ? ti + 1 : 32 - ti)];
            o[2 * k] = cr * a.x - cim * a.y; o[2 * k + 1] = -(cr * a.y + cim * a.x); }
        u32x4 w; w.x = pk2(o[0], o[1]); w.y = pk2(o[2], o[3]); w.z = pk2(o[4], o[5]); w.w = pk2(o[6], o[7]);
        *(u32x4*)(ME + ((size_t)g * 512 + rr) * 768 + 512 + dir * 128 + p0 * 2) = w;
    }
    __syncthreads();
    for (int it = bx; it < S5G * 2 * 4; it += G) {
        const int dq = it & 3, dir = (it >> 2) & 1, g = it >> 3;
        f32x2v* sC = (f32x2v*)lds;
        f32x2v* sA = sC + 1024;
        f32x2v* sB = sA + 512;
        for (int q = tid; q < 1024; q += NTHREADS) { const size_t ci_ = (size_t)(dir * S5G + g) * 1024 + q; sC[q] = (f32x2v){P.in[17][ci_], P.in[18][ci_]}; }
        { const int p = tid >> 3, dl = tid & 7; sA[tid] = AP[((g * 2 + dir) * S5P + p) * 33 + dq * 8 + dl]; }
        for (int q = tid; q < 1024; q += NTHREADS) sB[q] = BBAR[(size_t)(g * 2 + dir) * 1024 + q];
        __syncthreads();
        const int c4 = tid & 3, co = (tid >> 2) & 15, dl = tid >> 6;
        float o[4] = {0.f, 0.f, 0.f, 0.f};
        for (int p = 0; p < S5P; ++p) { const f32x2v cc = sC[co * 64 + p], a = sA[p * 8 + dl]; const float gr = cc.x * a.x - cc.y * a.y, gi = cc.x * a.y + cc.y * a.x;
#pragma unroll
            for (int k = 0; k < 4; ++k) { const f32x2v bb = sB[p * 16 + c4 * 4 + k]; o[k] += gr * bb.x - gi * bb.y; } }
        *(f32x4*)(KT + ((((size_t)g * 2 + dir) * 32 + dq * 8 + dl) * 16 + co) * 16 + c4 * 4) = (f32x4){o[0], o[1], o[2], o[3]};
        __syncthreads();
    }
    }
    xcd_barrier(xbar);

    if (PHASES & (1 << 2)) {
    PHASE_IDS
    for (long i = gt; i < (long)S5G * 512 * 64; i += NGT) {
        const int c8 = (int)(i & 1), j = (int)((i >> 1) & 31), rr = (int)((i >> 6) & 511), g = (int)(i >> 15);
        const int ti = rr >> 4, co = rr & 15;
        float o[8];
#pragma unroll
        for (int k = 0; k < 8; ++k) o[k] = 0.f;
        if (j <= ti) { const float* kp = KT + ((((size_t)g * 2 + 0) * 32 + (ti - j)) * 16 + co) * 16 + c8 * 8;
#pragma unroll
            for (int k = 0; k < 8; ++k) o[k] += kp[k]; }
        if (j >= ti) { const float* kp = KT + ((((size_t)g * 2 + 1) * 32 + (j - ti)) * 16 + co) * 16 + c8 * 8;
#pragma unroll
            for (int k = 0; k < 8; ++k) o[k] += kp[k]; }
        if (j == ti && (co >> 3) == c8) { const float dv = P.in[19][g * 16 + co];
#pragma unroll
            for (int k = 0; k < 8; ++k) if (k == (co & 7)) o[k] += dv; }
        u32x4 w; w.x = pk2(o[0], o[1]); w.y = pk2(o[2], o[3]); w.z = pk2(o[4], o[5]); w.w = pk2(o[6], o[7]);
        *(u32x4*)(ME + ((size_t)g * 512 + rr) * 768 + j * 16 + c8 * 8) = w;
    }
    __syncthreads();
    {
        pg8::Gemm g{XN, WIN, 1024, 1024, 1024}; pg8::StaticOrder S; S.init(MALL, 1280, G, bx);
        EpiIn E{PQ, PKV, SS, Kb, A2, rope};
        pg8::gemm_phase<EpiIn, pg8::StaticOrder, true>(ldsl, g, S, E);
    }
    }
    xcd_barrier(xbar);

    if (PHASES & (1 << 3)) {
    PHASE_IDS
#ifndef DSEL
#define DSEL 7
#endif
    if (DSEL & 1) {
        pg8::Gemm g{A2, FM, 512, 768, 512}; SchedS1 S{G, (bx + G - 96) % G};
        EpiS1 E{LB};
        pg8::gemm_phase<EpiS1, SchedS1, true>(ldsl, g, S, E);
    }
    if (DSEL & 2) {
        pg8::Gemm g{PQ, WUQ, QLR, QLR, QLR}; pg8::StaticOrder S; S.init(MLAT, 768, G, bx);
        EpiQ E{Qb, SS, rope};
        pg8::gemm_phase<EpiQ, pg8::StaticOrder, true>(ldsl, g, S, E);
    }
    if (DSEL & 4) {
        pg8::Gemm g{PKV, WKV, KVLR, KVLR, KVLR}; pg8::StaticOrder S; S.init(MALL, 1024, G, bx);
        EpiKV E{Kb, Vb, SS};
        pg8::gemm_phase<EpiKV, pg8::StaticOrder, true>(ldsl, g, S, E);
    }
    }
    xcd_barrier(xbar);

    if (PHASES & (1 << 4)) {
    PHASE_IDS
    for (int it = bx; it < S5G * NB * 2; it += G) {
        const int dir = it & 1, b = (it >> 1) & 7, g = it >> 4, p = lane, seg = wave;
        const f32x2v at = AP[((g * 2 + dir) * S5P + p) * 33 + 32];
        f32x2v* sS = (f32x2v*)lds;
        const size_t colL = dir * 128 + p * 2;
        f32x2v lv[17]; int nn[17];
#pragma unroll
        for (int k = 0; k < 17; ++k) { const int s_ = seg * 17 + k;
            int n; if (dir == 0) n = s_ < 8 ? 1024 + b * 8 + s_ : b * 128 + (s_ - 8); else n = s_ < 8 ? 1024 + b * 8 + (7 - s_) : b * 128 + (135 - s_);
            nn[k] = n; lv[k] = *(const f32x2v*)(LB + ((size_t)g * NCH + n) * 256 + colL); }
        float hr = 0.f, hi_ = 0.f;
#pragma unroll
        for (int k = 0; k < 17; ++k) { const float nr = at.x * hr - at.y * hi_ + lv[k].x, ni = at.x * hi_ + at.y * hr + lv[k].y; hr = nr; hi_ = ni; }
        sS[seg * 64 + p] = (f32x2v){hr, hi_};
        float pr = at.x, pi = at.y;
#pragma unroll
        for (int k = 0; k < 16; ++k) { const float nr = pr * at.x - pi * at.y, ni = pr * at.y + pi * at.x; pr = nr; pi = ni; }
        __syncthreads();
        hr = 0.f; hi_ = 0.f;
        for (int q = 0; q < seg; ++q) { const f32x2v sv = sS[q * 64 + p]; const float nr = pr * hr - pi * hi_ + sv.x, ni = pr * hi_ + pi * hr + sv.y; hr = nr; hi_ = ni; }
#pragma unroll
        for (int k = 0; k < 17; ++k) {
            *(unsigned*)(A2 + ((size_t)g * NCH + nn[k]) * 768 + 512 + colL) = pk2(hr, hi_);
            const float nr = at.x * hr - at.y * hi_ + lv[k].x, ni = at.x * hi_ + at.y * hr + lv[k].y; hr = nr; hi_ = ni;
        }
        __syncthreads();
    }
    }
    xcd_barrier(xbar);

    if (PHASES & (1 << 5)) {
    PHASE_IDS
    {
        pg8::Gemm g{A2, ME, 768, 768, 768}; SchedS2 S{G, bx};
        EpiS2 E{Zb};
        pg8::gemm_phase<EpiS2, SchedS2, true>(ldsl, g, S, E);
    }
    __syncthreads();
#ifndef ATT_REP
#define ATT_REP 1
#endif
    for (int rep = 0; rep < ATT_REP; ++rep)
    for (int i = 0; i < 4; ++i) {
        const int ui = i * G + vcu; if (ui >= NB * NH * 16) break;
        const int bh = ui >> 4, qb = ui & 15, b = bh >> 3, h = bh & 7;
        att::attn_unit(Qb + ((size_t)bh * SEQ + qb * 256) * 96, Kb + (size_t)bh * LK * 96, Vb + (size_t)bh * LK * 64,
                       CAT + ((size_t)b * SEQ + qb * 256) * DM + h * 64, (char*)lds);
    }
    }
    xcd_barrier(xbar);

    if (PHASES & (1 << 6)) {
    PHASE_IDS
    {
        pg8::Gemm g{Zb, WGLU, 512, 512, 512}; pg8::StaticOrder S; S.init(MLAT, 512, G, bx);
        EpiGlu E{Zb, CAT, P.in[21]};
        pg8::gemm_phase<EpiGlu, pg8::StaticOrder, true>(ldsl, g, S, E);
    }
    }
    xcd_barrier(xbar);

    if (PHASES & (1 << 7)) {
    PHASE_IDS
    {
        pg8::Gemm g{CAT, WOUT, 1024, 1024, 1024}; pg8::StaticOrder S; S.init(MLAT, 1024, G, bx);
        EpiRes E{x, P.out, mods + 2048};
        pg8::gemm_phase<EpiRes, pg8::StaticOrder, true>(ldsl, g, S, E);
    }
    }
    xcd_barrier(xbar);

    if (PHASES & (1 << 8)) {
    PHASE_IDS
    for (int row = gw; row < MLAT; row += NGW) {
        const int r = row >> 12;
        f32x4* xr = (f32x4*)(P.out + (size_t)row * DM) + lane; f32x4 v[4];
#pragma unroll
        for (int j = 0; j < 4; ++j) v[j] = xr[64 * j];
        float mean, rstd; row_stats(v, mean, rstd);
        const f32x4* gp = (const f32x4*)P.in[23] + lane; const f32x4* bp = (const f32x4*)P.in[24] + lane;
#pragma unroll
        for (int j = 0; j < 4; ++j) { v[j] = (v[j] - mean) * rstd * gp[64 * j] + bp[64 * j]; xr[64 * j] = v[j]; }
        row_stats(v, mean, rstd);
        const f32x4* sh = (const f32x4*)(mods + r * 6144 + 3072) + lane; const f32x4* scl = (const f32x4*)(mods + r * 6144 + 4096) + lane;
        unsigned long long* o8 = (unsigned long long*)(XN + (size_t)row * DM) + lane;
#pragma unroll
        for (int j = 0; j < 4; ++j) { const f32x4 s_ = sh[64 * j], c_ = scl[64 * j]; const f32x4 y = (v[j] - mean) * rstd * (c_ + 1.0f) + s_;
            o8[64 * j] = (unsigned long long)pk2(y[0], y[1]) | ((unsigned long long)pk2(y[2], y[3]) << 32); }
    }
    }
    xcd_barrier(xbar);

    if (PHASES & (1 << 9)) {
    PHASE_IDS
    {
        pg8::Gemm g{XN, WGU, 1024, 1024, 1024}; pg8::StaticOrder S; S.init(MLAT, 2 * DFF, G, bx);
        EpiGU E{HB};
        pg8::gemm_phase<EpiGU, pg8::StaticOrder, true>(ldsl, g, S, E);
    }
    }
    xcd_barrier(xbar);

    if (PHASES & (1 << 10)) {
    PHASE_IDS
    {
        pg8::Gemm g{HB, WDN, DFF, DFF, DFF}; pg8::StaticOrder S; S.init(MLAT, 1024, G, bx);
        EpiRes E{P.out, P.out, mods + 5120};
        pg8::gemm_phase<EpiRes, pg8::StaticOrder, true>(ldsl, g, S, E);
    }
    }
    xcd_barrier(xbar);

    if (PHASES & (1 << 11)) {
    PHASE_IDS
    for (int row = gw; row < MLAT; row += NGW) {
        f32x4* xr = (f32x4*)(P.out + (size_t)row * DM) + lane; f32x4 v[4];
#pragma unroll
        for (int j = 0; j < 4; ++j) v[j] = xr[64 * j];
        float mean, rstd; row_stats(v, mean, rstd);
        const f32x4* gp = (const f32x4*)P.in[27] + lane; const f32x4* bp = (const f32x4*)P.in[28] + lane;
#pragma unroll
        for (int j = 0; j < 4; ++j) xr[64 * j] = (v[j] - mean) * rstd * gp[64 * j] + bp[64 * j];
    }
    }
}

extern "C" void kernel_launch(void* const* d_in, const int* in_sizes, int n_in, void* d_out, int out_size, void* d_ws, size_t ws_size, hipStream_t stream) {
    static int grid = 0;
    if (grid == 0) {
        if (n_in != 29 || in_sizes[0] != MLAT * DM || out_size != MLAT * DM || ws_size < WS_END) {
            fprintf(stderr, "kernel_launch: unexpected shapes: n_in %d in0 %d out %d ws %zu (need >= %zu)\n", n_in, n_in > 0 ? in_sizes[0] : -1, out_size, ws_size, (size_t)WS_END); grid = -1; return; }
        int dev = 0, cus = 0, per_cu = 0;
        if (hipGetDevice(&dev) != hipSuccess || hipDeviceGetAttribute(&cus, hipDeviceAttributeMultiprocessorCount, dev) != hipSuccess) { grid = -1; return; }
        if (hipFuncSetAttribute((const void*)hymba_fwd, hipFuncAttributeMaxDynamicSharedMemorySize, LDS_BYTES) != hipSuccess) { fprintf(stderr, "kernel_launch: hipFuncSetAttribute failed\n"); grid = -1; return; }
        if (hipOccupancyMaxActiveBlocksPerMultiprocessor(&per_cu, (const void*)hymba_fwd, NTHREADS, LDS_BYTES) != hipSuccess || per_cu < 1) { fprintf(stderr, "kernel_launch: occupancy query says %d\n", per_cu); per_cu = 1; }
        (void)hipGetLastError();
        grid = cus * per_cu;
    }
    if (grid < 0) return;
    Params p{};
    for (int i = 0; i < 29; ++i) p.in[i] = (const float*)d_in[i];
    p.out = (float*)d_out; p.ws = (unsigned char*)d_ws;
    void* args[] = {&p};
    hipError_t e = hipLaunchCooperativeKernel((const void*)hymba_fwd, dim3(grid), dim3(NTHREADS), args, LDS_BYTES, stream);
    if (e != hipSuccess) fprintf(stderr, "kernel_launch: cooperative launch failed: %s (grid %d)\n", hipGetErrorString(e), grid);
}
```
